# Optimizing an MI355X kernel written in HIP

```python
import math
import jax, jax.numpy as jnp
from jax import lax
import numpy as np

D_MODEL = 1024
BATCH = 4
SEQ = 8192
DEPTH = 2

N_EVEN = (DEPTH + 1) // 2
N_ODD = DEPTH // 2
EPS = 1e-6

SSD_D_INNER = D_MODEL
SSD_HEAD_DIM = 64
SSD_N_HEADS = SSD_D_INNER // SSD_HEAD_DIM
SSD_N_GROUPS = 2
SSD_D_STATE = 128
SSD_CONV = 4
SSD_CHUNK = 128
SSD_CONV_DIM = SSD_D_INNER + 2 * SSD_N_GROUPS * SSD_D_STATE

S5_WIDTH = D_MODEL
S5_GROUP = 16
S5_N_GROUPS = S5_WIDTH // S5_GROUP
S5_STATE = 64

HYB_IN = SSD_D_INNER + SSD_CONV_DIM + SSD_N_HEADS + S5_WIDTH
HYB_OUT = SSD_D_INNER + S5_WIDTH

ATT_HEAD_DIM = 128
ATT_KV_HEADS = D_MODEL // ATT_HEAD_DIM
ATT_PATTERNS = ((128, 1), (512, 4), (2048, 16))
ATT_N_PAT = len(ATT_PATTERNS)
ATT_Q_HEADS = ATT_N_PAT * ATT_KV_HEADS
ATT_BLOCK = 128
ATT_QKV = (ATT_Q_HEADS + 2 * ATT_KV_HEADS) * ATT_HEAD_DIM
ATT_OUT = ATT_KV_HEADS * ATT_HEAD_DIM

FFN_HIDDEN = -((-8 * D_MODEL) // (3 * 256)) * 256

kernel_name = "hybrid_ssd_s5_dilated_attn_trunk"


def rms_norm(x, g):
    x32 = x.astype(jnp.float32)
    y = x32 * lax.rsqrt(jnp.mean(x32 * x32, axis=-1, keepdims=True) + EPS)
    return (y * g.astype(jnp.float32)).astype(x.dtype)


def causal_dwconv(x, w, b):
    y = lax.conv_general_dilated(
        x, w[:, None, :].astype(x.dtype), window_strides=(1,),
        padding=[(w.shape[0] - 1, 0)], dimension_numbers=('NWC', 'WIO', 'NWC'),
        feature_group_count=x.shape[-1])
    return y + b.astype(x.dtype)


def ssd_scan(x, a, b, c):
    bs, l, h, p = x.shape
    g, n = b.shape[2], b.shape[3]
    r = h // g
    t = SSD_CHUNK
    nc = l // t
    xc = x.reshape(bs, nc, t, g, r, p)
    ac = jnp.cumsum(a.reshape(bs, nc, t, g, r), axis=2)
    bc = b.reshape(bs, nc, t, g, n)
    cc = c.reshape(bs, nc, t, g, n)
    causal = jnp.tril(jnp.ones((t, t), bool))[:, :, None, None]
    decay = jnp.exp(jnp.where(causal, ac[:, :, :, None] - ac[:, :, None, :], -jnp.inf))
    cb = jnp.einsum('bclgn,bcsgn->bclsg', cc, bc)
    y_diag = jnp.einsum('bclsg,bclsgr,bcsgrp->bclgrp', cb, decay, xc)
    decay_to_end = jnp.exp(ac[:, :, -1:] - ac)
    states = jnp.einsum('bcsgn,bcsgr,bcsgrp->bcgrpn', bc, decay_to_end, xc)
    chunk_decay = jnp.exp(ac[:, :, -1])

    def step(h_prev, inp):
        dec, st = inp
        return dec[..., None, None] * h_prev + st, h_prev

    h0 = jnp.zeros((bs, g, r, p, n), x.dtype)
    _, prev = lax.scan(step, h0, (jnp.moveaxis(chunk_decay, 1, 0), jnp.moveaxis(states, 1, 0)))
    prev = jnp.moveaxis(prev, 0, 1)
    y_off = jnp.einsum('bclgn,bcgrpn,bclgr->bclgrp', cc, prev, jnp.exp(ac))
    return (y_diag + y_off).reshape(bs, l, h, p)


def ssd_mixer(z, xbc, dt_raw, conv_w, conv_b, dt_bias, a_log, d_skip, norm_g):
    f32 = jnp.float32
    bs, l, _ = z.shape
    gn = SSD_N_GROUPS * SSD_D_STATE
    xbc = jax.nn.silu(causal_dwconv(xbc, conv_w, conv_b)).astype(f32)
    xs = xbc[..., :SSD_D_INNER].reshape(bs, l, SSD_N_HEADS, SSD_HEAD_DIM)
    bm = xbc[..., SSD_D_INNER:SSD_D_INNER + gn].reshape(bs, l, SSD_N_GROUPS, SSD_D_STATE)
    cm = xbc[..., SSD_D_INNER + gn:].reshape(bs, l, SSD_N_GROUPS, SSD_D_STATE)
    dt = jax.nn.softplus(dt_raw.astype(f32) + dt_bias.astype(f32))
    a = -jnp.exp(a_log.astype(f32))
    y = ssd_scan(xs * dt[..., None], dt * a, bm, cm) + d_skip.astype(f32)[:, None] * xs
    y = y.reshape(bs, l, SSD_D_INNER) * jax.nn.silu(z.astype(f32))
    yg = y.reshape(bs, l, SSD_N_GROUPS, SSD_D_INNER // SSD_N_GROUPS)
    yg = yg * lax.rsqrt(jnp.mean(yg * yg, axis=-1, keepdims=True) + EPS)
    return (yg.reshape(bs, l, SSD_D_INNER) * norm_g.astype(f32)).astype(z.dtype)


def complex_linear_combine(e1, e2):
    a1r, a1i, b1r, b1i = e1
    a2r, a2i, b2r, b2i = e2
    return (a2r * a1r - a2i * a1i, a2r * a1i + a2i * a1r,
            a2r * b1r - a2i * b1i + b2r, a2r * b1i + a2i * b1r + b2i)


def s5_mixer(u, lam_re, lam_im, log_dt, b_re, b_im, c_re, c_im, d_skip, glu_w, glu_b):
    f32 = jnp.float32
    bs, l, _ = u.shape
    lam_re, lam_im = lam_re.astype(f32), lam_im.astype(f32)
    dt = jnp.exp(log_dt.astype(f32))[:, None]
    mag = jnp.exp(lam_re * dt)
    a_re, a_im = mag * jnp.cos(lam_im * dt), mag * jnp.sin(lam_im * dt)
    den = lam_re * lam_re + lam_im * lam_im
    q_re = ((a_re - 1.0) * lam_re + a_im * lam_im) / den
    q_im = (a_im * lam_re - (a_re - 1.0) * lam_im) / den
    b_re, b_im = b_re.astype(f32), b_im.astype(f32)
    bb_re = q_re[..., None] * b_re - q_im[..., None] * b_im
    bb_im = q_re[..., None] * b_im + q_im[..., None] * b_re
    c_re, c_im = c_re.astype(f32), c_im.astype(f32)
    u_g = u.astype(f32).reshape(bs, l, S5_N_GROUPS, S5_GROUP)

    def run_sequence(us):
        bu_re = jnp.einsum('lgc,gpc->lgp', us, bb_re)
        bu_im = jnp.einsum('lgc,gpc->lgp', us, bb_im)
        ar = jnp.broadcast_to(a_re, bu_re.shape)
        ai = jnp.broadcast_to(a_im, bu_re.shape)
        _, _, h_re, h_im = lax.associative_scan(complex_linear_combine, (ar, ai, bu_re, bu_im), axis=0)
        return jnp.einsum('lgp,gcp->lgc', h_re, c_re) - jnp.einsum('lgp,gcp->lgc', h_im, c_im)

    y = lax.map(run_sequence, u_g)
    y = y + d_skip.astype(f32).reshape(S5_N_GROUPS, S5_GROUP) * u_g
    y = jax.nn.gelu(y.reshape(bs, l, S5_WIDTH), approximate=False)
    y = y * jax.nn.sigmoid(y @ glu_w.astype(f32) + glu_b.astype(f32))
    return y.astype(u.dtype)


def dilated_window_attention(q, k, v, window, dilation):
    bs, l, h, e = q.shape
    span = window // dilation
    unit = dilation * ATT_BLOCK
    lp = -(-l // unit) * unit
    m = lp // dilation
    nb = m // ATT_BLOCK

    def to_blocks(t):
        t = jnp.pad(t, ((0, 0), (0, lp - l), (0, 0), (0, 0))).reshape(bs, m, dilation, h, e)
        return jnp.swapaxes(t, 1, 2).reshape(bs, dilation, nb, ATT_BLOCK, h, e)

    def with_prev(t):
        prev = jnp.pad(t, ((0, 0), (0, 0), (1, 0), (0, 0), (0, 0), (0, 0)))[:, :, :-1]
        return jnp.concatenate([prev, t], axis=3)

    qb = to_blocks(q)
    kb = with_prev(to_blocks(k))
    vb = with_prev(to_blocks(v))
    s = jnp.einsum('brnqhe,brnkhe->brnhqk', qb, kb).astype(jnp.float32) * (e ** -0.5)
    qi = jnp.arange(ATT_BLOCK)[:, None]
    kj = jnp.arange(2 * ATT_BLOCK)[None, :]
    dist = ATT_BLOCK + qi - kj
    band = (dist >= 0) & (dist <= span)
    has_prev = jnp.arange(nb)[:, None, None] > 0
    valid = band[None] & (has_prev | (kj >= ATT_BLOCK)[None])
    s = jnp.where(valid[:, None], s, -jnp.inf)
    s_max = jnp.max(s, axis=-1, keepdims=True)
    p = jnp.exp(s - s_max)
    den = jnp.sum(p, axis=-1, keepdims=True)
    o = jnp.einsum('brnhqk,brnkhe->brnqhe', p / den, vb.astype(jnp.float32))
    lse = (s_max + jnp.log(den))[..., 0]
    o = jnp.swapaxes(o.reshape(bs, dilation, m, h, e), 1, 2).reshape(bs, lp, h, e)[:, :l]
    lse = jnp.swapaxes(jnp.swapaxes(lse, 3, 4).reshape(bs, dilation, m, h), 1, 2).reshape(bs, lp, h)[:, :l]
    return o, lse


def dilated_attention_mixer(h, w_qkv, w_o):
    bs, l, _ = h.shape
    nq = ATT_Q_HEADS * ATT_HEAD_DIM
    nk = ATT_KV_HEADS * ATT_HEAD_DIM
    qkv = h @ w_qkv
    q = qkv[..., :nq].reshape(bs, l, ATT_N_PAT, ATT_KV_HEADS, ATT_HEAD_DIM)
    k = qkv[..., nq:nq + nk].reshape(bs, l, ATT_KV_HEADS, ATT_HEAD_DIM)
    v = qkv[..., nq + nk:].reshape(bs, l, ATT_KV_HEADS, ATT_HEAD_DIM)
    outs, lses = [], []
    for i, (window, dilation) in enumerate(ATT_PATTERNS):
        o, lse = dilated_window_attention(q[:, :, i], k, v, window, dilation)
        outs.append(o)
        lses.append(lse)
    wts = jax.nn.softmax(jnp.stack(lses), axis=0)
    o = jnp.sum(wts[..., None] * jnp.stack(outs), axis=0)
    return o.reshape(bs, l, ATT_OUT).astype(h.dtype) @ w_o


def swiglu(h, w_in, w_out):
    g, u = jnp.split(h @ w_in, 2, axis=-1)
    return (jax.nn.silu(g) * u) @ w_out


def setup_inputs(seed: int = 0) -> dict:
    key = jax.random.key(seed)
    ks = jax.random.split(key, 32)
    f32 = jnp.float32

    def nrm(k, shape, scale):
        return jax.random.normal(k, shape, f32) * scale

    D = D_MODEL
    dt0 = jnp.exp(jax.random.uniform(ks[12], (N_EVEN, SSD_N_HEADS), f32, math.log(1e-3), math.log(1e-1)))
    lam_im = jnp.pi * jnp.arange(S5_STATE, dtype=f32)
    return {
        "x": nrm(ks[0], (BATCH, SEQ, D), 1.0),
        "c": nrm(ks[1], (BATCH, D), 1.0),
        "ada_w": nrm(ks[2], (DEPTH, D, 6 * D), 0.5 * D ** -0.5),
        "ada_b": nrm(ks[3], (DEPTH, 6 * D), 0.02),
        "mix_pre_g": 1.0 + nrm(ks[4], (DEPTH, D), 0.02),
        "mix_post_g": 1.0 + nrm(ks[5], (DEPTH, D), 0.02),
        "ffn_pre_g": 1.0 + nrm(ks[6], (DEPTH, D), 0.02),
        "ffn_post_g": 1.0 + nrm(ks[7], (DEPTH, D), 0.02),
        "ffn_w_in": nrm(ks[8], (DEPTH, D, 2 * FFN_HIDDEN), D ** -0.5),
        "ffn_w_out": nrm(ks[9], (DEPTH, FFN_HIDDEN, D), FFN_HIDDEN ** -0.5),
        "hyb_w_in": nrm(ks[10], (N_EVEN, D, HYB_IN), D ** -0.5),
        "ssd_conv_w": nrm(ks[11], (N_EVEN, SSD_CONV, SSD_CONV_DIM), SSD_CONV ** -0.5),
        "ssd_conv_b": nrm(ks[13], (N_EVEN, SSD_CONV_DIM), 0.02),
        "ssd_dt_bias": dt0 + jnp.log(-jnp.expm1(-dt0)),
        "ssd_a_log": jnp.log(jax.random.uniform(ks[14], (N_EVEN, SSD_N_HEADS), f32, 1.0, 16.0)),
        "ssd_d": 1.0 + nrm(ks[15], (N_EVEN, SSD_N_HEADS), 0.1),
        "ssd_norm_g": 1.0 + nrm(ks[16], (N_EVEN, SSD_D_INNER), 0.02),
        "s5_lambda_re": -0.5 + nrm(ks[17], (N_EVEN, S5_N_GROUPS, S5_STATE), 0.01),
        "s5_lambda_im": lam_im + nrm(ks[18], (N_EVEN, S5_N_GROUPS, S5_STATE), 0.01),
        "s5_log_dt": jax.random.uniform(ks[19], (N_EVEN, S5_N_GROUPS), f32, math.log(1e-3), math.log(1e-1)),
        "s5_b_re": nrm(ks[20], (N_EVEN, S5_N_GROUPS, S5_STATE, S5_GROUP), (2 * S5_GROUP) ** -0.5),
        "s5_b_im": nrm(ks[21], (N_EVEN, S5_N_GROUPS, S5_STATE, S5_GROUP), (2 * S5_GROUP) ** -0.5),
        "s5_c_re": nrm(ks[22], (N_EVEN, S5_N_GROUPS, S5_GROUP, S5_STATE), (2 * S5_STATE) ** -0.5),
        "s5_c_im": nrm(ks[23], (N_EVEN, S5_N_GROUPS, S5_GROUP, S5_STATE), (2 * S5_STATE) ** -0.5),
        "s5_d": nrm(ks[24], (N_EVEN, S5_WIDTH), 1.0),
        "s5_glu_w": nrm(ks[25], (N_EVEN, S5_WIDTH, S5_WIDTH), S5_WIDTH ** -0.5),
        "s5_glu_b": nrm(ks[26], (N_EVEN, S5_WIDTH), 0.02),
        "hyb_w_out": nrm(ks[27], (N_EVEN, HYB_OUT, D), HYB_OUT ** -0.5),
        "attn_w_qkv": nrm(ks[28], (N_ODD, D, ATT_QKV), D ** -0.5),
        "attn_w_o": nrm(ks[29], (N_ODD, ATT_OUT, D), ATT_OUT ** -0.5),
    }


def reference(x, c, ada_w, ada_b, mix_pre_g, mix_post_g, ffn_pre_g, ffn_post_g,
              ffn_w_in, ffn_w_out, hyb_w_in, ssd_conv_w, ssd_conv_b, ssd_dt_bias,
              ssd_a_log, ssd_d, ssd_norm_g, s5_lambda_re, s5_lambda_im, s5_log_dt,
              s5_b_re, s5_b_im, s5_c_re, s5_c_im, s5_d, s5_glu_w, s5_glu_b,
              hyb_w_out, attn_w_qkv, attn_w_o):
    cond = jax.nn.silu(c)
    split_at = [SSD_D_INNER, SSD_D_INNER + SSD_CONV_DIM, SSD_D_INNER + SSD_CONV_DIM + SSD_N_HEADS]
    for i in range(DEPTH):
        mod = (cond @ ada_w[i] + ada_b[i])[:, None, :]
        sh_m, sc_m, gt_m, sh_f, sc_f, gt_f = jnp.split(mod, 6, axis=-1)
        h = rms_norm(x, mix_pre_g[i]) * (1 + sc_m) + sh_m
        j = i // 2
        if i % 2 == 0:
            proj = h @ hyb_w_in[j]
            z, xbc, dt_raw, u = jnp.split(proj, split_at, axis=-1)
            y_ssd = ssd_mixer(z, xbc, dt_raw, ssd_conv_w[j], ssd_conv_b[j], ssd_dt_bias[j],
                              ssd_a_log[j], ssd_d[j], ssd_norm_g[j])
            y_s5 = s5_mixer(u, s5_lambda_re[j], s5_lambda_im[j], s5_log_dt[j], s5_b_re[j],
                            s5_b_im[j], s5_c_re[j], s5_c_im[j], s5_d[j], s5_glu_w[j], s5_glu_b[j])
            y = jnp.concatenate([y_ssd, y_s5], axis=-1) @ hyb_w_out[j]
        else:
            y = dilated_attention_mixer(h, attn_w_qkv[j], attn_w_o[j])
        x = x + gt_m * rms_norm(y, mix_post_g[i])
        h = rms_norm(x, ffn_pre_g[i]) * (1 + sc_f) + sh_f
        x = x + gt_f * rms_norm(swiglu(h, ffn_w_in[i], ffn_w_out[i]), ffn_post_g[i])
    return x
```

```cpp
#include <hip/hip_runtime.h>
#include <hip/hip_cooperative_groups.h>
#include <cstdio>
#include <cstdint>
namespace cg = cooperative_groups;

#define LAS __attribute__((address_space(3)))
typedef unsigned short bf16;
typedef short bf16x8 __attribute__((ext_vector_type(8)));
typedef float f32x4 __attribute__((ext_vector_type(4)));
typedef unsigned u32x4 __attribute__((ext_vector_type(4)));
typedef unsigned u32x2 __attribute__((ext_vector_type(2)));

#ifndef N_LAUNCH_PER_PHASE
#define N_LAUNCH_PER_PHASE 0
#endif

constexpr int NTOK = 32768, DM = 1024, SEQ = 8192, NPH = 22;
constexpr float EPS = 1e-6f;
constexpr size_t MiB = 1u << 20;
constexpr size_t WS_MOD = 0;
constexpr size_t WS_A16 = 256 * 1024;
constexpr size_t WS_CD = 320 * 1024;
constexpr size_t WS_BAR = 512 * 1024;
constexpr size_t WS_LSE = 1 * MiB;
constexpr size_t WS_WHYBIN = 2 * MiB, WS_WGLU = 9 * MiB, WS_WHYBOUT = 11 * MiB, WS_WFFIN = 15 * MiB, WS_WFFOUT = 37 * MiB,
                 WS_WQKV = 48 * MiB, WS_WO = 58 * MiB, WS_TOEC = 60 * MiB, WS_BPOW = 72 * MiB, WS_DTRAW = 80 * MiB;
constexpr size_t WS_H = 84 * MiB, WS_Y = 148 * MiB, WS_BIG = 212 * MiB;
constexpr size_t WS_Z = WS_BIG;
constexpr size_t WS_XBC = WS_BIG + 64 * MiB;
constexpr size_t WS_UG = WS_BIG + 160 * MiB;
constexpr size_t WS_HID = WS_BIG;
constexpr size_t WS_QKV = 192 * MiB;
constexpr size_t WS_SSDST = WS_H;
constexpr size_t WS_HLOC = WS_Y;
constexpr size_t WS_S5Y = WS_Y;
constexpr size_t WS_O = WS_H;
constexpr size_t WS_XB2 = 388 * MiB;
constexpr size_t WS_END = 512 * MiB;
constexpr int LDS_BYTES = 155648;
#ifndef LAUNCH_LIST
#define LAUNCH_LIST 0, NPH
#endif
#ifndef REP_LIST
#define REP_LIST 1,1,1,1,1,1,1,1,1,1,1,1,1,1,1,1,1,1,1,1,1,1
#endif
constexpr int REP[22] = {REP_LIST};

struct Params { const float* in[30]; float* out; unsigned char* ws; int ph_lo, ph_hi, li, pad; };

__device__ __forceinline__ unsigned f2bf(float f) { unsigned u = __builtin_bit_cast(unsigned, f); return (u + 0x7fffu + ((u >> 16) & 1u)) >> 16; }
typedef __bf16 bf16x2_t __attribute__((ext_vector_type(2)));
typedef float f32x2_t __attribute__((ext_vector_type(2)));
__device__ __forceinline__ unsigned pk2(float lo, float hi) { const f32x2_t v = {lo, hi}; return __builtin_bit_cast(unsigned, __builtin_convertvector(v, bf16x2_t)); }
__device__ __forceinline__ float bf2f(unsigned b) { return __builtin_bit_cast(float, b << 16); }
__device__ __forceinline__ float bflo(unsigned w) { return __builtin_bit_cast(float, w << 16); }
__device__ __forceinline__ float bfhi(unsigned w) { return __builtin_bit_cast(float, w & 0xffff0000u); }
__device__ __forceinline__ void unpack8(u32x4 r, float* v) { v[0] = bflo(r.x); v[1] = bfhi(r.x); v[2] = bflo(r.y); v[3] = bfhi(r.y); v[4] = bflo(r.z); v[5] = bfhi(r.z); v[6] = bflo(r.w); v[7] = bfhi(r.w); }
__device__ __forceinline__ float wave_sum(float v) {
#pragma unroll
    for (int o = 1; o < 64; o <<= 1) v += __shfl_xor(v, o);
    return v;
}
__device__ __forceinline__ float siluf(float x) { return x * __builtin_amdgcn_rcpf(1.f + __expf(-x)); }
__device__ __forceinline__ float sigmf(float x) { return __builtin_amdgcn_rcpf(1.f + __expf(-x)); }
__device__ __forceinline__ int kperm(int k) { return (k & ~31) | (((k >> 2) & 3) << 3) | (((k >> 4) & 1) << 2) | (k & 3); }
__device__ __forceinline__ float gelu_erf(float v) {
    const float av = fabsf(v), t = __builtin_amdgcn_rcpf(av * 0.2316418882f + 1.0f);
    float q = t * 0.5307027145f + (-0.7265760135f); q = q * t + 0.7107068705f; q = q * t + (-0.142248368f); q = q * t + 0.127414796f; q = q * t;
    const float e = __builtin_amdgcn_exp2f((v * v) * (-0.72134752044f));
    const float m = v * (q * e);
    return v < 0.f ? m : v - m;
}
#define LDS_WAIT() asm volatile("s_waitcnt lgkmcnt(0)" ::: "memory")
#define WAVE_SYNC() do { asm volatile("s_waitcnt lgkmcnt(0)" ::: "memory"); __builtin_amdgcn_wave_barrier(); } while (0)
#define MFMA16(a, b, c) __builtin_amdgcn_mfma_f32_16x16x32_bf16((a), (b), (c), 0, 0, 0)

namespace pg8 {
constexpr int BM = 256, BK = 64, HALF = 128, HTB = HALF * BK * 2, STAGE_BYTES = 8 * HTB, NXCD = 8, WGM = 8;
__device__ __forceinline__ int lds_byte(int r, int c) { const int st = (r >> 4) * 2 + (c >> 5), rr = r & 15, cc = c & 31, ob = rr * 64 + cc * 2; return st * 1024 + (ob ^ (((ob >> 9) & 1) << 5)); }
__device__ __forceinline__ void stage_rc(int b, int& R, int& C) { const int st = b / 1024, sb = b % 1024, swz = sb ^ (((sb >> 9) & 1) << 5); R = (st >> 1) * 16 + swz / 64; C = (st & 1) * 32 + (swz % 64) / 2; }
__device__ __forceinline__ int perm32(int rho) { const int n = rho >> 4, i = rho & 15; return 8 * (i >> 2) + 4 * n + (i & 3); }

struct Unit { int pm, pn, pb; };
struct Gemm { const bf16* A; const bf16* Bt; int lda, ldb, K; };

struct StaticOrder {
    int nM, nN, nwg, G, c;
    __device__ void init(int M, int N, int G_, int c_) { nM = M / BM; nN = N / BM; nwg = nM * nN; G = G_; c = c_; }
    __device__ bool next(int i, Unit& u) const {
        const long L = (long)i * G + c; if (L >= nwg) return false;
        int wgid = (int)L; { const int q = nwg / NXCD, r = nwg % NXCD, xcd = wgid % NXCD, off = wgid / NXCD; wgid = (xcd < r ? xcd * (q + 1) : r * (q + 1) + (xcd - r) * q) + off; }
        const int nig = WGM * nN, gid = wgid / nig, fm = gid * WGM, gsz = (nM - fm) < WGM ? (nM - fm) : WGM;
        u.pm = fm + ((wgid % nig) % gsz); u.pn = (wgid % nig) / gsz; u.pb = u.pn; return true;
    }
};
struct GroupOrder {
    int G, c;
    __device__ bool next(int i, Unit& u) const { const int L = i * G + c; if (L >= 512) return false; u.pm = L; u.pn = 0; u.pb = L >> 3; return true; }
};

template <class Epi, class Sched>
__device__ __forceinline__ void gemm_phase(LAS unsigned char* lds, const Gemm g, const Sched& S, const Epi& E) {
    const int tid = threadIdx.x, wid = __builtin_amdgcn_readfirstlane(tid >> 6), lane = tid & 63, wr = wid >> 2, wc = wid & 3, fr = lane & 15, fq = lane >> 4;
    const int K = g.K, nt = K / BK;
    unsigned voffA[2], voffB[2];
#pragma unroll
    for (int i = 0; i < 2; ++i) { int R, C; stage_rc(tid * 16 + i * 8192, R, C); const int Rb = (R & ~31) + perm32(R & 31);
        voffA[i] = (unsigned)(R * g.lda + C) * 2u; voffB[i] = (unsigned)(Rb * g.ldb + C) * 2u; }
    const size_t kstep = (size_t)(BK * 2);
    const size_t hA = (size_t)HALF * g.lda * 2, hB = (size_t)HALF * g.ldb * 2, tA = 2 * hA, tB = 2 * hB;
    const unsigned ldsw = (unsigned)wid * 1024u;
    const int aoff = lds_byte(wr * 64 + fr, fq * 8), boff = lds_byte(wc * 32 + fr, fq * 8);
#define PG8_SA(b, h) (((b) * 2 + (h)) * HTB)
#define PG8_SB(b, h) ((4 + (b) * 2 + (h)) * HTB)
#define PG8_STAGE(bufoff, gbase, voff) do { _Pragma("unroll") for (int _i = 0; _i < 2; ++_i) \
        __builtin_amdgcn_global_load_lds((const unsigned*)((const char*)(gbase) + (voff)[_i]), (LAS unsigned*)(lds + (bufoff) + ldsw + _i * 8192), 16, 0, 0); } while (0)
#define PG8_LDA(dst, b, h) do { _Pragma("unroll") for (int m = 0; m < 4; ++m) _Pragma("unroll") for (int k = 0; k < 2; ++k) dst[m][k] = *(const LAS bf16x8*)(lds + PG8_SA(b, h) + aoff + m * 2048 + k * 1024); } while (0)
#define PG8_LDB(dst, b, h) do { _Pragma("unroll") for (int n = 0; n < 2; ++n) _Pragma("unroll") for (int k = 0; k < 2; ++k) dst[n][k] = *(const LAS bf16x8*)(lds + PG8_SB(b, h) + boff + n * 2048 + k * 1024); } while (0)
#define PG8_MMA(ai, bj, At, Bt) do { __builtin_amdgcn_s_setprio(1); _Pragma("unroll") for (int m = 0; m < 4; ++m) _Pragma("unroll") for (int n = 0; n < 2; ++n) _Pragma("unroll") for (int k = 0; k < 2; ++k) \
        acc[ai][bj][m][n] = __builtin_amdgcn_mfma_f32_16x16x32_bf16(Bt[n][k], At[m][k], acc[ai][bj][m][n], 0, 0, 0); __builtin_amdgcn_s_setprio(0); } while (0)
#define PG8_WAIT_V(n) asm volatile("s_waitcnt vmcnt(" #n ")" ::: "memory")
#define PG8_WAIT_L(n) asm volatile("s_waitcnt lgkmcnt(" #n ")" ::: "memory")
#define PG8_BAR __builtin_amdgcn_s_barrier()
#define PG8_SCHED __builtin_amdgcn_sched_barrier(0)
    Unit cur, nxt; int ui = 0;
    if (!S.next(0, cur)) return;
    f32x4 acc[2][2][4][2];
#pragma unroll
    for (int a = 0; a < 2; ++a)
#pragma unroll
        for (int b = 0; b < 2; ++b)
#pragma unroll
            for (int m = 0; m < 4; ++m)
#pragma unroll
                for (int n = 0; n < 2; ++n) acc[a][b][m][n] = (f32x4){0.f, 0.f, 0.f, 0.f};
    bf16x8 At[4][2], B0[2][2], B1[2][2];
    const char* cA = (const char*)g.A + (size_t)cur.pm * tA; const char* cB = (const char*)g.Bt + (size_t)cur.pb * tB;
    {
        PG8_STAGE(PG8_SB(0, 0), cB, voffB); PG8_STAGE(PG8_SB(0, 1), cB + hB, voffB); PG8_STAGE(PG8_SA(0, 0), cA, voffA); PG8_STAGE(PG8_SA(0, 1), cA + hA, voffA);
        if (wr == 1) PG8_BAR;
        PG8_WAIT_V(2); PG8_BAR;
        PG8_STAGE(PG8_SB(1, 0), cB + kstep, voffB); PG8_STAGE(PG8_SA(1, 0), cA + kstep, voffA); PG8_STAGE(PG8_SB(1, 1), cB + hB + kstep, voffB);
        PG8_WAIT_V(6); PG8_BAR;
    }
    for (;;) {
        const bool has_next = S.next(ui + 1, nxt);
        const char* nA = has_next ? (const char*)g.A + (size_t)nxt.pm * tA : cA; const char* nB = has_next ? (const char*)g.Bt + (size_t)nxt.pb * tB : cB;
#pragma unroll 1
        for (int t = 0; t < nt; t += 2) {
            const bool last = (t == nt - 2);
            const char* a1 = cA + (size_t)(t + 1) * kstep;
            const char* a2 = last ? nA : cA + (size_t)(t + 2) * kstep; const char* b2 = last ? nB : cB + (size_t)(t + 2) * kstep;
            const char* a3 = a2 + kstep; const char* b3 = b2 + kstep;
            PG8_LDB(B0, 0, 0); PG8_LDB(B1, 0, 1); PG8_SCHED; PG8_LDA(At, 0, 0); PG8_STAGE(PG8_SA(1, 1), a1 + hA, voffA);
            PG8_WAIT_V(8); PG8_WAIT_L(0); PG8_BAR; PG8_MMA(0, 0, At, B0); PG8_MMA(0, 1, At, B1); PG8_BAR; PG8_SCHED;
            PG8_LDA(At, 0, 1); PG8_STAGE(PG8_SB(0, 0), b2, voffB); PG8_STAGE(PG8_SB(0, 1), b2 + hB, voffB); PG8_STAGE(PG8_SA(0, 0), a2, voffA);
            PG8_WAIT_V(8); PG8_WAIT_L(0); PG8_BAR; PG8_MMA(1, 0, At, B0); PG8_MMA(1, 1, At, B1); PG8_BAR; PG8_SCHED;
            PG8_LDB(B0, 1, 0); PG8_LDB(B1, 1, 1); PG8_SCHED; PG8_LDA(At, 1, 0); PG8_STAGE(PG8_SA(0, 1), a2 + hA, voffA);
            PG8_WAIT_V(8); PG8_WAIT_L(0); PG8_BAR; PG8_MMA(0, 0, At, B0); PG8_MMA(0, 1, At, B1); PG8_BAR; PG8_SCHED;
            PG8_LDA(At, 1, 1); PG8_STAGE(PG8_SB(1, 0), b3, voffB); PG8_STAGE(PG8_SB(1, 1), b3 + hB, voffB); PG8_STAGE(PG8_SA(1, 0), a3, voffA);
            PG8_WAIT_V(8); PG8_WAIT_L(0); PG8_BAR; PG8_MMA(1, 0, At, B0); PG8_MMA(1, 1, At, B1); PG8_BAR; PG8_SCHED;
        }
        if (wr == 0) PG8_BAR;
        E(acc, cur, wr, wc, fr, fq);
        if (!has_next) break;
#pragma unroll
        for (int a = 0; a < 2; ++a)
#pragma unroll
            for (int b = 0; b < 2; ++b)
#pragma unroll
                for (int m = 0; m < 4; ++m)
#pragma unroll
                    for (int n = 0; n < 2; ++n) acc[a][b][m][n] = (f32x4){0.f, 0.f, 0.f, 0.f};
        cur = nxt; cA = nA; cB = nB; ++ui;
        if (wr == 1) PG8_BAR;
    }
    PG8_WAIT_V(0);
    PG8_BAR;
#undef PG8_SA
#undef PG8_SB
#undef PG8_STAGE
#undef PG8_LDA
#undef PG8_LDB
#undef PG8_MMA
#undef PG8_WAIT_V
#undef PG8_WAIT_L
#undef PG8_BAR
#undef PG8_SCHED
}

#define EPI_LOOP_BEGIN \
    _Pragma("unroll") for (int ai = 0; ai < 2; ++ai) _Pragma("unroll") for (int m = 0; m < 4; ++m) { const int row = u.pm * BM + ai * HALF + wr * 64 + m * 16 + fr; \
    _Pragma("unroll") for (int bj = 0; bj < 2; ++bj) { const int col = u.pn * BM + bj * HALF + wc * 32 + 8 * fq; const f32x4 v0 = acc[ai][bj][m][0], v1 = acc[ai][bj][m][1];
#define EPI_LOOP_END } }
__device__ __forceinline__ u32x4 pack8(f32x4 a, f32x4 b) { u32x4 w; w.x = pk2(a[0], a[1]); w.y = pk2(a[2], a[3]); w.z = pk2(b[0], b[1]); w.w = pk2(b[2], b[3]); return w; }

struct EpiPlain { bf16* O; int ldc;
    __device__ __forceinline__ void operator()(const f32x4 (&acc)[2][2][4][2], const Unit& u, int wr, int wc, int fr, int fq) const {
        EPI_LOOP_BEGIN
            *(u32x4*)(O + (size_t)row * ldc + col) = pack8(v0, v1);
        EPI_LOOP_END
    } };
struct EpiHybIn { bf16* z; bf16* xraw; bf16* ug;
    __device__ __forceinline__ void operator()(const f32x4 (&acc)[2][2][4][2], const Unit& u, int wr, int wc, int fr, int fq) const {
        EPI_LOOP_BEGIN
            if (u.pn < 4) *(u32x4*)(z + (size_t)row * 1024 + col) = pack8(v0, v1);
            else if (u.pn < 10) *(u32x4*)(xraw + (size_t)row * 1536 + (col - 1024)) = pack8(v0, v1);
            else { const int j = col - 2560, gg = j >> 4, cp = j & 15, chunk = row >> 4, s = row & 15;
                   *(u32x4*)(ug + ((size_t)(gg * 2048 + chunk)) * 384 + s * 16 + cp) = pack8(v0, v1); }
        EPI_LOOP_END
    } };
struct EpiQKV { bf16* base;
    __device__ __forceinline__ void operator()(const f32x4 (&acc)[2][2][4][2], const Unit& u, int wr, int wc, int fr, int fq) const {
        EPI_LOOP_BEGIN
            const int sect = col >> 10, hh = (col >> 7) & 7, d = col & 127, b = row >> 13, t = row & 8191;
            *(u32x4*)(base + (((size_t)(sect * 4 + b) * 8 + hh) * 8192 + t) * 128 + d) = pack8(v0, v1);
        EPI_LOOP_END
    } };
struct EpiSwiglu { bf16* hid;
    __device__ __forceinline__ void operator()(const f32x4 (&acc)[2][2][4][2], const Unit& u, int wr, int wc, int fr, int fq) const {
#pragma unroll
        for (int ai = 0; ai < 2; ++ai)
#pragma unroll
            for (int m = 0; m < 4; ++m) { const int row = u.pm * BM + ai * HALF + wr * 64 + m * 16 + fr; const int col = u.pn * 128 + wc * 32 + 8 * fq;
                f32x4 r0, r1;
#pragma unroll
                for (int i = 0; i < 4; ++i) { r0[i] = siluf(acc[ai][0][m][0][i]) * acc[ai][1][m][0][i]; r1[i] = siluf(acc[ai][0][m][1][i]) * acc[ai][1][m][1][i]; }
                *(u32x4*)(hid + (size_t)row * 2816 + col) = pack8(r0, r1); }
    } };
struct EpiGlu { const bf16* y; const float* gb; bf16* ycat;
    __device__ __forceinline__ void operator()(const f32x4 (&acc)[2][2][4][2], const Unit& u, int wr, int wc, int fr, int fq) const {
        EPI_LOOP_BEGIN
            float yv[8]; unpack8(*(const u32x4*)(y + (size_t)row * 1024 + col), yv);
            const f32x4 b0 = *(const f32x4*)(gb + col), b1 = *(const f32x4*)(gb + col + 4); f32x4 r0, r1;
#pragma unroll
            for (int i = 0; i < 4; ++i) { r0[i] = yv[i] * sigmf(v0[i] + b0[i]); r1[i] = yv[4 + i] * sigmf(v1[i] + b1[i]); }
            *(u32x4*)(ycat + (size_t)row * 2048 + 1024 + col) = pack8(r0, r1);
            __builtin_amdgcn_sched_barrier(0);
        EPI_LOOP_END
    } };
struct EpiS5State { float* hloc;
    __device__ __forceinline__ void operator()(const f32x4 (&acc)[2][2][4][2], const Unit& u, int wr, int wc, int fr, int fq) const {
#pragma unroll
        for (int ai = 0; ai < 2; ++ai)
#pragma unroll
            for (int m = 0; m < 4; ++m) { const int row = u.pm * BM + ai * HALF + wr * 64 + m * 16 + fr; const int col = wc * 32 + 8 * fq;
                *(f32x4*)(hloc + (size_t)row * 128 + col) = acc[ai][0][m][0]; *(f32x4*)(hloc + (size_t)row * 128 + col + 4) = acc[ai][0][m][1]; }
    } };
struct EpiS5Y { const bf16* ug; const float* dsk; bf16* s5y;
    __device__ __forceinline__ void operator()(const f32x4 (&acc)[2][2][4][2], const Unit& u, int wr, int wc, int fr, int fq) const {
        EPI_LOOP_BEGIN
            const int gg = row >> 11, chunk = row & 2047, t = col >> 4, c0 = col & 15, tok = chunk * 16 + t, ch = gg * 16 + c0;
            f32x4 r0, r1;
#pragma unroll
            for (int i = 0; i < 4; ++i) { r0[i] = gelu_erf(v0[i]); r1[i] = gelu_erf(v1[i]); }
            *(u32x4*)(s5y + (size_t)tok * 1024 + ch) = pack8(r0, r1);
            __builtin_amdgcn_sched_barrier(0);
        EPI_LOOP_END
    } };
}

__device__ __forceinline__ void tr_item(const float* W, int N, int src_c0, bf16* WT, int K, int dst_r0, int k0, LAS float* scr, int lane) {
    f32x4 v[16];
    const int kr = lane >> 4, nc = (lane & 15) * 4;
#pragma unroll
    for (int i = 0; i < 16; ++i) v[i] = *(const f32x4*)(W + (size_t)(k0 + 4 * i + kr) * N + src_c0 + nc);
#pragma unroll
    for (int i = 0; i < 16; ++i) { LAS float* d = scr + (4 * i + kr) * 65 + nc; d[0] = v[i][0]; d[1] = v[i][1]; d[2] = v[i][2]; d[3] = v[i][3]; }
    LDS_WAIT(); __builtin_amdgcn_wave_barrier();
    const int c = lane & 7;
#pragma unroll
    for (int j = 0; j < 8; ++j) { const int n = (lane >> 3) + 8 * j; const LAS float* q = scr + (8 * c) * 65 + n;
        u32x4 o; o.x = pk2(q[0 * 65], q[1 * 65]); o.y = pk2(q[2 * 65], q[3 * 65]); o.z = pk2(q[4 * 65], q[5 * 65]); o.w = pk2(q[6 * 65], q[7 * 65]);
        *(u32x4*)(WT + (size_t)(dst_r0 + n) * K + k0 + 8 * c) = o; }
    LDS_WAIT(); __builtin_amdgcn_wave_barrier();
}

template <int MAP>
__device__ __forceinline__ void tr_matrix_item(const float* W, int N, bf16* WT, int K, int NR, int item, LAS float* scr, int lane) {
    const int nrb = NR / 64, kb = item / nrb, rb = item % nrb, r0 = rb * 64;
    int sc;
    if (MAP == 0) sc = r0;
    else if (MAP == 1) sc = r0 < 2560 ? r0 : r0 + 16;
    else { const int t = r0 >> 8, w = r0 & 255; sc = w < 128 ? 128 * t + w : 2816 + 128 * t + (w - 128); }
    tr_item(W, N, sc, WT, K, r0, kb * 64, scr, lane);
}

__device__ __forceinline__ void phase_prologue(const Params& P, LAS unsigned char* lds) {
    const int tid = threadIdx.x, lane = tid & 63, wave = __builtin_amdgcn_readfirstlane(tid >> 6);
    unsigned char* ws = P.ws;
    {
        const int g = blockIdx.x >> 2, q = blockIdx.x & 3;
        LAS float* pwr = (LAS float*)lds;
        LAS float* pwi = pwr + 17 * 64;
        LAS float* qq = pwi + 17 * 64;
        LAS float* bbr = qq + 128;
        LAS float* bbi = bbr + 1024;
        LAS float* ccr = bbi + 1024;
        LAS float* cci = ccr + 1024;
        LAS float* Kd = cci + 1024;
        LAS float* dsk = Kd + 4096;
        const float* lam_re = P.in[17]; const float* lam_im = P.in[18]; const float* log_dt = P.in[19];
        const float* b_re = P.in[20]; const float* b_im = P.in[21]; const float* c_re = P.in[22]; const float* c_im = P.in[23];
        if (tid < 16) dsk[tid] = P.in[24][g * 16 + tid];
        for (int e = tid; e < 17 * 64; e += 512) { const int p = e & 63, d = e >> 6; const float lre = lam_re[g * 64 + p], lim = lam_im[g * 64 + p], dt = expf(log_dt[g]);
            const float mag = expf(lre * dt * (float)d), ang = lim * dt * (float)d; pwr[d * 64 + p] = mag * cosf(ang); pwi[d * 64 + p] = mag * sinf(ang); }
        __syncthreads();
        if (tid < 64) {
            const int p = tid; const float lre = lam_re[g * 64 + p], lim = lam_im[g * 64 + p];
            const float are = pwr[64 + p], aim = pwi[64 + p], den = lre * lre + lim * lim;
            qq[2 * p] = ((are - 1.f) * lre + aim * lim) / den; qq[2 * p + 1] = (aim * lre - (are - 1.f) * lim) / den;
            if (q == 0) { float* a16 = (float*)(ws + WS_A16); a16[(g * 64 + p) * 2] = pwr[16 * 64 + p]; a16[(g * 64 + p) * 2 + 1] = pwi[16 * 64 + p]; }
        }
        __syncthreads();
        for (int e = tid; e < 1024; e += 512) { const int p = e >> 4, cp = e & 15; const float br = b_re[(g * 64 + p) * 16 + cp], bi = b_im[(g * 64 + p) * 16 + cp], qr = qq[2 * p], qi = qq[2 * p + 1];
            bbr[e] = qr * br - qi * bi; bbi[e] = qr * bi + qi * br;
            const int c = e >> 6, p2 = e & 63; ccr[e] = c_re[(g * 16 + c) * 64 + p2]; cci[e] = c_im[(g * 16 + c) * 64 + p2]; }
        __syncthreads();
        for (int e = tid; e < 1024; e += 512) { const int d = e >> 6, c = 4 * q + ((e >> 4) & 3), cp = e & 15; float s = 0.f;
            for (int p = 0; p < 64; ++p) { const float pr = pwr[d * 64 + p], pi = pwi[d * 64 + p], br = bbr[p * 16 + cp], bi = bbi[p * 16 + cp];
                const float tr = pr * br - pi * bi, ti = pr * bi + pi * br; s += ccr[c * 64 + p] * tr - cci[c * 64 + p] * ti; }
            Kd[(d * 16 + c) * 16 + cp] = s; }
        __syncthreads();
        bf16* toec = (bf16*)(ws + WS_TOEC) + (size_t)g * 256 * 384;
        for (int e = tid; e < 64 * 384; e += 512) { const int rl = e / 384, k = e % 384, t = rl >> 2, c = 4 * q + (rl & 3), n = t * 16 + c; float val;
            if (k < 256) { const int s = k >> 4, cp = k & 15; val = t >= s ? Kd[((t - s) * 16 + c) * 16 + cp] : 0.f; if (t == s && c == cp) val += dsk[c]; }
            else { const int j = k - 256, p = j & 63; const float pr = pwr[(t + 1) * 64 + p], pi = pwi[(t + 1) * 64 + p], cr = ccr[c * 64 + p], ci = cci[c * 64 + p];
                   val = j < 64 ? (cr * pr - ci * pi) : -(cr * pi + ci * pr); }
            toec[n * 384 + k] = (bf16)f2bf(val); }
        bf16* bpow = (bf16*)(ws + WS_BPOW) + (size_t)g * 256 * 256;
        for (int e = tid; e < 64 * 256; e += 512) { const int n = 64 * q + (e >> 8), k = e & 255; float val = 0.f;
            if (n < 128) { const int p = n & 63, s = k >> 4, cp = k & 15; const float pr = pwr[(15 - s) * 64 + p], pi = pwi[(15 - s) * 64 + p], br = bbr[p * 16 + cp], bi = bbi[p * 16 + cp];
                val = n < 64 ? (pr * br - pi * bi) : (pr * bi + pi * br); }
            bpow[n * 256 + k] = (bf16)f2bf(val); }
        __syncthreads();
    }
    const int bxi = (int)blockIdx.x, trwg = bxi < 64 ? bxi : bxi - 48;
    const int gw = (bxi >= 64 && bxi < 112) ? -1 : trwg * 8 + wave, NGW = ((int)gridDim.x - 48) * 8;
    {
        const float* cvec = P.in[1]; const float* ada_w = P.in[2]; const float* ada_b = P.in[3]; float* mod = (float*)(ws + WS_MOD);
        LAS float* part = (LAS float*)lds;
        LAS float* cond = part + 8 * 4 * 256;
        if ((int)blockIdx.x >= 64 && (int)blockIdx.x < 112) { for (int e = tid; e < 4096; e += 512) cond[e] = siluf(cvec[e]); __syncthreads(); }
        for (int it = (int)blockIdx.x - 64; it >= 0 && it < 48; it += gridDim.x) {
            const int li = it / 24, cb = it % 24, col = cb * 256 + 4 * lane;
            f32x4 a0 = {0.f, 0.f, 0.f, 0.f}, a1 = a0, a2 = a0, a3 = a0;
            const float* wp = ada_w + ((size_t)li * 1024 + wave * 128) * 6144 + col;
#pragma unroll 32
            for (int k = 0; k < 128; ++k) { const f32x4 w = *(const f32x4*)(wp + (size_t)k * 6144); const int kk = wave * 128 + k;
                a0 += w * cond[kk]; a1 += w * cond[1024 + kk]; a2 += w * cond[2048 + kk]; a3 += w * cond[3072 + kk]; }
            *(LAS f32x4*)(part + (wave * 4 + 0) * 256 + 4 * lane) = a0; *(LAS f32x4*)(part + (wave * 4 + 1) * 256 + 4 * lane) = a1;
            *(LAS f32x4*)(part + (wave * 4 + 2) * 256 + 4 * lane) = a2; *(LAS f32x4*)(part + (wave * 4 + 3) * 256 + 4 * lane) = a3;
            __syncthreads();
            { const int c = tid & 255, b0 = (tid >> 8) * 2;
#pragma unroll
              for (int bb = 0; bb < 2; ++bb) { float sacc = ada_b[li * 6144 + cb * 256 + c];
#pragma unroll
                  for (int w = 0; w < 8; ++w) sacc += part[(w * 4 + b0 + bb) * 256 + c];
                  mod[((size_t)li * 4 + b0 + bb) * 6144 + cb * 256 + c] = sacc; } }
            __syncthreads();
        }
    }
    {
        LAS float* scr = (LAS float*)lds + wave * (64 * 65);
        constexpr int I0 = 16 * 56, I1 = 16 * 16, I2 = 32 * 16, I3 = 16 * 88, I4 = 44 * 16, I5 = 16 * 80, I6 = 16 * 16;
        constexpr int NIT = I0 + I1 + I2 + 2 * I3 + 2 * I4 + I5 + I6;
        if (gw >= 0) for (int it = gw; it < NIT; it += NGW) {
            int r = it;
            if (r < I0) { tr_matrix_item<1>(P.in[10], 3600, (bf16*)(ws + WS_WHYBIN), 1024, 3584, r, scr, lane); continue; } r -= I0;
            if (r < I1) { tr_matrix_item<0>(P.in[25], 1024, (bf16*)(ws + WS_WGLU), 1024, 1024, r, scr, lane); continue; } r -= I1;
            if (r < I2) { tr_matrix_item<0>(P.in[27], 1024, (bf16*)(ws + WS_WHYBOUT), 2048, 1024, r, scr, lane); continue; } r -= I2;
            if (r < I3) { tr_matrix_item<2>(P.in[8], 5632, (bf16*)(ws + WS_WFFIN), 1024, 5632, r, scr, lane); continue; } r -= I3;
            if (r < I3) { tr_matrix_item<2>(P.in[8] + (size_t)1024 * 5632, 5632, (bf16*)(ws + WS_WFFIN) + (size_t)5632 * 1024, 1024, 5632, r, scr, lane); continue; } r -= I3;
            if (r < I4) { tr_matrix_item<0>(P.in[9], 1024, (bf16*)(ws + WS_WFFOUT), 2816, 1024, r, scr, lane); continue; } r -= I4;
            if (r < I4) { tr_matrix_item<0>(P.in[9] + (size_t)2816 * 1024, 1024, (bf16*)(ws + WS_WFFOUT) + (size_t)1024 * 2816, 2816, 1024, r, scr, lane); continue; } r -= I4;
            if (r < I5) { tr_matrix_item<0>(P.in[28], 5120, (bf16*)(ws + WS_WQKV), 1024, 5120, r, scr, lane); continue; } r -= I5;
            tr_matrix_item<0>(P.in[29], 1024, (bf16*)(ws + WS_WO), 1024, 1024, r, scr, lane);
        }
    }
}

template <int MODE, int XIN16, int XOUT16>
__device__ __forceinline__ void phase_norm(const Params& P, LAS unsigned char* lds, const void* xin_, void* xout_, const float* gpost, const float* modgt,
                                           const float* gpre, const float* modsc, const float* modsh) {
    const float* xin = (const float*)xin_; const bf16* xin16 = (const bf16*)xin_; float* xout = (float*)xout_; bf16* xout16 = (bf16*)xout_;
    const int tid = threadIdx.x, lane = tid & 63, wave = __builtin_amdgcn_readfirstlane(tid >> 6);
    unsigned char* ws = P.ws;
    LAS float* wdt = (LAS float*)lds;
    if (MODE == 0) {
        const float* W = P.in[10];
        for (int e = tid; e < 16 * 1024; e += 512) { const int k = e >> 4, o = e & 15; wdt[o * 1024 + k] = W[(size_t)k * 3600 + 2560 + o]; }
        __syncthreads();
    }
    const bf16* Y = (const bf16*)(ws + WS_Y); bf16* H = (bf16*)(ws + WS_H); float* dtraw = (float*)(ws + WS_DTRAW);
    const int gw = blockIdx.x * 8 + wave, NGW = gridDim.x * 8;
    f32x4 Gpost[4], Gpre[4];
#pragma unroll
    for (int j = 0; j < 4; ++j) { const int c = 4 * lane + 256 * j; if (MODE != 0) Gpost[j] = *(const f32x4*)(gpost + c); if (MODE != 2) Gpre[j] = *(const f32x4*)(gpre + c); }
    u32x2 c16[2][4], n16[2][4], yr[2][4], ny[2][4]; f32x4 c32[2][4], n32[2][4];
#define NORM_LOAD(R16, R32, YR, r0_) do { _Pragma("unroll") for (int rr_ = 0; rr_ < 2; ++rr_) { const size_t ro_ = (size_t)((r0_) + rr_ * NGW) * DM + 4 * lane; \
        _Pragma("unroll") for (int j_ = 0; j_ < 4; ++j_) { if (XIN16) R16[rr_][j_] = *(const u32x2*)(xin16 + ro_ + 256 * j_); else R32[rr_][j_] = *(const f32x4*)(xin + ro_ + 256 * j_); \
            if (MODE != 0) YR[rr_][j_] = *(const u32x2*)(Y + ro_ + 256 * j_); } } } while (0)
    NORM_LOAD(c16, c32, yr, gw);
    f32x4 Gt[4], Sc[4], Sh[4];
#pragma unroll 1
    for (int row0 = gw; row0 < NTOK; row0 += 2 * NGW) {
        if (row0 + 2 * NGW < NTOK) NORM_LOAD(n16, n32, ny, row0 + 2 * NGW);
        if (((row0 - gw) / (2 * NGW) & 1) == 0) {
            const int bq = row0 >> 13;
#pragma unroll
            for (int j = 0; j < 4; ++j) { const int c = 4 * lane + 256 * j; if (MODE != 0) Gt[j] = *(const f32x4*)(modgt + bq * 6144 + c);
                if (MODE != 2) { Sc[j] = *(const f32x4*)(modsc + bq * 6144 + c); Sh[j] = *(const f32x4*)(modsh + bq * 6144 + c); } } }
        f32x4 v[2][4];
#pragma unroll
        for (int rr = 0; rr < 2; ++rr)
#pragma unroll
            for (int j = 0; j < 4; ++j) { if (XIN16) v[rr][j] = (f32x4){bflo(c16[rr][j].x), bfhi(c16[rr][j].x), bflo(c16[rr][j].y), bfhi(c16[rr][j].y)}; else v[rr][j] = c32[rr][j]; }
#pragma unroll
        for (int rr = 0; rr < 2; ++rr) { const int row = row0 + rr * NGW;
        if (MODE != 0) {
            float s = 0.f;
#pragma unroll
            for (int j = 0; j < 4; ++j) { const f32x4 yy = {bflo(yr[rr][j].x), bfhi(yr[rr][j].x), bflo(yr[rr][j].y), bfhi(yr[rr][j].y)}; s += (yy[0] * yy[0] + yy[1] * yy[1]) + (yy[2] * yy[2] + yy[3] * yy[3]); }
            const float r1 = rsqrtf(wave_sum(s) * (1.f / DM) + EPS);
#pragma unroll
            for (int j = 0; j < 4; ++j) { const int c = 4 * lane + 256 * j; const f32x4 g = Gpost[j], gt = Gt[j];
                const f32x4 yy = {bflo(yr[rr][j].x), bfhi(yr[rr][j].x), bflo(yr[rr][j].y), bfhi(yr[rr][j].y)};
                v[rr][j] = v[rr][j] + gt * (yy * r1 * g);
                if (XOUT16) { u32x2 o; o.x = pk2(v[rr][j][0], v[rr][j][1]); o.y = pk2(v[rr][j][2], v[rr][j][3]); *(u32x2*)(xout16 + (size_t)row * DM + c) = o; }
                else *(f32x4*)(xout + (size_t)row * DM + c) = v[rr][j]; }
        }
        if (MODE != 2) {
            float s = 0.f;
#pragma unroll
            for (int j = 0; j < 4; ++j) s += (v[rr][j][0] * v[rr][j][0] + v[rr][j][1] * v[rr][j][1]) + (v[rr][j][2] * v[rr][j][2] + v[rr][j][3] * v[rr][j][3]);
            const float r2 = rsqrtf(wave_sum(s) * (1.f / DM) + EPS);
#pragma unroll
            for (int j = 0; j < 4; ++j) { const int c = 4 * lane + 256 * j; const f32x4 g = Gpre[j], sc = Sc[j], sh = Sh[j];
                v[rr][j] = (v[rr][j] * r2 * g) * (sc + 1.f) + sh;
                u32x2 o; o.x = pk2(v[rr][j][0], v[rr][j][1]); o.y = pk2(v[rr][j][2], v[rr][j][3]); *(u32x2*)(H + (size_t)row * DM + c) = o; }
            if (MODE == 0) {
                float a[16];
#pragma unroll
                for (int o = 0; o < 16; ++o) { float t = 0.f;
#pragma unroll
                    for (int j = 0; j < 4; ++j) { const f32x4 w = *(const LAS f32x4*)(wdt + o * 1024 + 4 * lane + 256 * j); t += (v[rr][j][0] * w[0] + v[rr][j][1] * w[1]) + (v[rr][j][2] * w[2] + v[rr][j][3] * w[3]); }
                    a[o] = t; if ((o & 1) == 1) __builtin_amdgcn_sched_barrier(0); }
#pragma unroll
                for (int i = 0; i < 8; ++i) { const bool up = lane & 32; const float keep = up ? a[i + 8] : a[i], send = up ? a[i] : a[i + 8]; a[i] = keep + __shfl_xor(send, 32); }
#pragma unroll
                for (int i = 0; i < 4; ++i) { const bool up = lane & 16; const float keep = up ? a[i + 4] : a[i], send = up ? a[i] : a[i + 4]; a[i] = keep + __shfl_xor(send, 16); }
#pragma unroll
                for (int i = 0; i < 2; ++i) { const bool up = lane & 8; const float keep = up ? a[i + 2] : a[i], send = up ? a[i] : a[i + 2]; a[i] = keep + __shfl_xor(send, 8); }
                { const bool up = lane & 4; const float keep = up ? a[1] : a[0], send = up ? a[0] : a[1]; a[0] = keep + __shfl_xor(send, 4); }
                a[0] += __shfl_xor(a[0], 2); a[0] += __shfl_xor(a[0], 1);
                if ((lane & 3) == 0) dtraw[(size_t)row * 16 + ((lane >> 5) & 1) * 8 + ((lane >> 4) & 1) * 4 + ((lane >> 3) & 1) * 2 + ((lane >> 2) & 1)] = a[0];
            }
        }
        }
#pragma unroll
        for (int rr = 0; rr < 2; ++rr)
#pragma unroll
            for (int j = 0; j < 4; ++j) { c16[rr][j] = n16[rr][j]; c32[rr][j] = n32[rr][j]; yr[rr][j] = ny[rr][j]; }
    }
#undef NORM_LOAD
    if (MODE == 0) __syncthreads();
}

__device__ __forceinline__ void phase_conv(const Params& P) {
    const int tid = threadIdx.x, lane = tid & 63, wave = __builtin_amdgcn_readfirstlane(tid >> 6);
    const bf16* xraw = (const bf16*)P.out; bf16* xbc = (bf16*)(P.ws + WS_XBC);
    const float* cw = P.in[11]; const float* cb = P.in[12];
    const int gw = blockIdx.x * 8 + wave, NGW = gridDim.x * 8;
    u32x4 rawn[11];
#define CONV_LOAD(R, iw_) do { const int rb_ = (iw_) / 3, cgb_ = (iw_) - rb_ * 3, ch_ = (cgb_ * 64 + lane) * 8, tk_ = rb_ * 8, ti_ = tk_ & 8191; \
        _Pragma("unroll") for (int r_ = 0; r_ < 11; ++r_) { if (ti_ + r_ - 3 >= 0) R[r_] = *(const u32x4*)(xraw + (size_t)(tk_ + r_ - 3) * 1536 + ch_); else R[r_] = (u32x4){0u, 0u, 0u, 0u}; } } while (0)
    if (gw < 4096 * 3) CONV_LOAD(rawn, gw);
#pragma unroll 1
    for (int iw = gw; iw < 4096 * 3; iw += NGW) {
        const int rb = iw / 3, cgb = iw - rb * 3, ch0 = (cgb * 64 + lane) * 8, tok0 = rb * 8;
        u32x4 raw[11];
#pragma unroll
        for (int r = 0; r < 11; ++r) raw[r] = rawn[r];
        if (iw + NGW < 4096 * 3) CONV_LOAD(rawn, iw + NGW);
        float w[4][8], bias[8];
#pragma unroll
        for (int k = 0; k < 4; ++k) { const f32x4 w0 = *(const f32x4*)(cw + k * 1536 + ch0), w1 = *(const f32x4*)(cw + k * 1536 + ch0 + 4);
            w[k][0] = w0[0]; w[k][1] = w0[1]; w[k][2] = w0[2]; w[k][3] = w0[3]; w[k][4] = w1[0]; w[k][5] = w1[1]; w[k][6] = w1[2]; w[k][7] = w1[3]; }
        { const f32x4 b0 = *(const f32x4*)(cb + ch0), b1 = *(const f32x4*)(cb + ch0 + 4); bias[0] = b0[0]; bias[1] = b0[1]; bias[2] = b0[2]; bias[3] = b0[3]; bias[4] = b1[0]; bias[5] = b1[1]; bias[6] = b1[2]; bias[7] = b1[3]; }
#pragma unroll
        for (int t = 0; t < 8; ++t) { float a[8];
#pragma unroll
            for (int e = 0; e < 8; ++e) a[e] = bias[e];
#pragma unroll
            for (int k = 0; k < 4; ++k) { float x[8]; unpack8(raw[t + k], x);
#pragma unroll
                for (int e = 0; e < 8; ++e) a[e] += w[k][e] * x[e]; }
            u32x4 o; o.x = pk2(siluf(a[0]), siluf(a[1])); o.y = pk2(siluf(a[2]), siluf(a[3])); o.z = pk2(siluf(a[4]), siluf(a[5])); o.w = pk2(siluf(a[6]), siluf(a[7]));
            *(u32x4*)(xbc + (size_t)(tok0 + t) * 1536 + ch0) = o; }
    }
}
__device__ __forceinline__ unsigned pair_lo(unsigned a, unsigned c) { return (a & 0xffffu) | (c << 16); }
__device__ __forceinline__ unsigned pair_hi(unsigned a, unsigned c) { return (a >> 16) | (c & 0xffff0000u); }
__device__ __forceinline__ void ssd_dt_acum(const Params& P, LAS float* DT, LAS float* AC, int tok0, int h, int hh, int lane) {
    const float* dtraw = (const float*)(P.ws + WS_DTRAW);
    const float bias = P.in[13][h], A = -expf(P.in[14][h]);
    float carry = 0.f;
#pragma unroll
    for (int half = 0; half < 2; ++half) {
        const int s = lane + 64 * half; const float raw = dtraw[(size_t)(tok0 + s) * 16 + h] + bias;
        const float dt = raw > 20.f ? raw : log1pf(expf(raw));
        float v = dt * A;
#pragma unroll
        for (int o = 1; o < 64; o <<= 1) { const float t = __shfl_up(v, o); if (lane >= o) v += t; }
        v += carry; carry = __shfl(v, 63);
        DT[hh * 128 + s] = dt; AC[hh * 128 + s] = v;
    }
}

__device__ __forceinline__ void ssd_local_unit(const Params& P, LAS unsigned char* lds, int unit) {
    const int tid = threadIdx.x, lane = tid & 63, wave = __builtin_amdgcn_readfirstlane(tid >> 6), fr = lane & 15, fq = lane >> 4;
    const int gq = unit & 1, c = (unit >> 1) & 63, b = unit >> 7, tok0 = b * SEQ + c * 128, h = gq * 8 + wave;
    const bf16* xbc = (const bf16*)(P.ws + WS_XBC);
    LAS bf16* BT = (LAS bf16*)lds;
    LAS unsigned* BT32 = (LAS unsigned*)lds;
    LAS float* DT = (LAS float*)(lds + 34816);
    LAS float* AC = (LAS float*)(lds + 38912);
    LAS bf16* XsT = (LAS bf16*)(lds + 43008 + wave * 9216);
    LAS unsigned* XsT32 = (LAS unsigned*)(lds + 43008 + wave * 9216);
    u32x4 br[2][2], xr0[4][2], xr1[4][2];
#pragma unroll
    for (int r = 0; r < 2; ++r) { const bf16* bp = xbc + (size_t)(tok0 + 2 * lane) * 1536 + 1024 + gq * 128 + (wave + 8 * r) * 8; br[r][0] = *(const u32x4*)bp; br[r][1] = *(const u32x4*)(bp + 1536); }
#define SL_XLOAD(XR, half_) do { _Pragma("unroll") for (int it_ = 0; it_ < 4; ++it_) { const int pg_ = (lane >> 5) + 2 * it_; \
        const bf16* xp_ = xbc + (size_t)(tok0 + 64 * (half_) + 2 * (lane & 31)) * 1536 + h * 64 + pg_ * 8; XR[it_][0] = *(const u32x4*)xp_; XR[it_][1] = *(const u32x4*)(xp_ + 1536); } } while (0)
    SL_XLOAD(xr0, 0);
    SL_XLOAD(xr1, 1);
    ssd_dt_acum(P, DT, AC, tok0, h, wave, lane);
#pragma unroll
    for (int r = 0; r < 2; ++r) { const int ng = wave + 8 * r;
        const u32x4 a = br[r][0], cc = br[r][1];
        LAS unsigned* d = BT32 + (ng * 8) * 68 + lane;
        d[0] = pair_lo(a.x, cc.x); d[68] = pair_hi(a.x, cc.x); d[2 * 68] = pair_lo(a.y, cc.y); d[3 * 68] = pair_hi(a.y, cc.y);
        d[4 * 68] = pair_lo(a.z, cc.z); d[5 * 68] = pair_hi(a.z, cc.z); d[6 * 68] = pair_lo(a.w, cc.w); d[7 * 68] = pair_hi(a.w, cc.w); }
    __syncthreads();
    f32x4 acc[4][8];
#pragma unroll
    for (int mt = 0; mt < 4; ++mt)
#pragma unroll
        for (int nt = 0; nt < 8; ++nt) acc[mt][nt] = (f32x4){0.f, 0.f, 0.f, 0.f};
    const float aend = AC[wave * 128 + 127];
#define SL_HALF(XR, half_) do { \
        { const int i_ = lane & 31, s0_ = 64 * (half_) + 2 * i_; \
          const float sc0_ = DT[wave * 128 + s0_] * __expf(aend - AC[wave * 128 + s0_]), sc1_ = DT[wave * 128 + s0_ + 1] * __expf(aend - AC[wave * 128 + s0_ + 1]); \
          _Pragma("unroll") for (int it_ = 0; it_ < 4; ++it_) { const int pg_ = (lane >> 5) + 2 * it_; float x0_[8], x1_[8]; unpack8(XR[it_][0], x0_); unpack8(XR[it_][1], x1_); \
              LAS unsigned* d_ = XsT32 + (pg_ * 8) * 36 + i_; \
              _Pragma("unroll") for (int e_ = 0; e_ < 8; ++e_) d_[e_ * 36] = pk2(x0_[e_] * sc0_, x1_[e_] * sc1_); } } \
        WAVE_SYNC(); \
        _Pragma("unroll") for (int ks = 0; ks < 2; ++ks) { \
            bf16x8 af[4]; \
            _Pragma("unroll") for (int mt = 0; mt < 4; ++mt) af[mt] = *(const LAS bf16x8*)(XsT + (16 * mt + fr) * 72 + 32 * ks + 8 * fq); \
            _Pragma("unroll") for (int nt = 0; nt < 8; ++nt) { const bf16x8 bfr = *(const LAS bf16x8*)(BT + (16 * nt + fr) * 136 + 64 * (half_) + 32 * ks + 8 * fq); \
                _Pragma("unroll") for (int mt = 0; mt < 4; ++mt) acc[mt][nt] = MFMA16(bfr, af[mt], acc[mt][nt]); } } \
        WAVE_SYNC(); } while (0)
    SL_HALF(xr0, 0);
    SL_HALF(xr1, 1);
#undef SL_XLOAD
#undef SL_HALF
    bf16* S = (bf16*)(P.ws + WS_SSDST) + ((size_t)((b * 64 + c) * 16 + h)) * 8192;
#pragma unroll
    for (int mt = 0; mt < 4; ++mt)
#pragma unroll
        for (int nt = 0; nt < 8; ++nt) { u32x2 o; o.x = pk2(acc[mt][nt][0], acc[mt][nt][1]); o.y = pk2(acc[mt][nt][2], acc[mt][nt][3]);
            *(u32x2*)(S + (16 * mt + fr) * 128 + 16 * nt + 4 * fq) = o; }
    if (lane == 0) ((float*)(P.ws + WS_CD))[(b * 64 + c) * 16 + h] = __expf(aend);
    __syncthreads();
}

__device__ __forceinline__ void phase_scans(const Params& P) {
    const int tid = threadIdx.x;
    if (blockIdx.x < 32) {
        const int idx = blockIdx.x * 512 + tid, p = idx & 63, g = (idx >> 6) & 63, b = idx >> 12;
        const float* a16 = (const float*)(P.ws + WS_A16); const float ar = a16[(g * 64 + p) * 2], ai = a16[(g * 64 + p) * 2 + 1];
        const float* hl = (const float*)(P.ws + WS_HLOC) + ((size_t)(g * 2048 + b * 512)) * 128 + p;
        bf16* ug = (bf16*)(P.ws + WS_UG) + ((size_t)(g * 2048 + b * 512)) * 384 + 256 + p;
        float hr = 0.f, hi = 0.f;
        float lr0[16], li0[16], lr1[16], li1[16];
#define S5_LD(LR, LI, c0_) do { _Pragma("unroll") for (int i_ = 0; i_ < 16; ++i_) { LR[i_] = hl[(size_t)((c0_) + i_) * 128]; LI[i_] = hl[(size_t)((c0_) + i_) * 128 + 64]; } } while (0)
#define S5_RUN(LR, LI, c0_) do { _Pragma("unroll") for (int i_ = 0; i_ < 16; ++i_) { ug[(size_t)((c0_) + i_) * 384] = (bf16)f2bf(hr); ug[(size_t)((c0_) + i_) * 384 + 64] = (bf16)f2bf(hi); \
            const float nr_ = ar * hr - ai * hi + LR[i_], ni_ = ar * hi + ai * hr + LI[i_]; hr = nr_; hi = ni_; } } while (0)
        S5_LD(lr0, li0, 0);
#pragma unroll 1
        for (int c0 = 0; c0 < 512; c0 += 32) {
            S5_LD(lr1, li1, c0 + 16);
            S5_RUN(lr0, li0, c0);
            if (c0 + 32 < 512) S5_LD(lr0, li0, c0 + 32);
            S5_RUN(lr1, li1, c0 + 16);
        }
#undef S5_LD
#undef S5_RUN
    } else {
        const float* cd = (const float*)(P.ws + WS_CD);
        for (int it = (blockIdx.x - 32) * 512 + tid; it < 65536; it += (gridDim.x - 32) * 512) {
            const int off = (it & 1023) * 8, h = (it >> 10) & 15, b = it >> 14;
            bf16* S = (bf16*)(P.ws + WS_SSDST) + ((size_t)(b * 64) * 16 + h) * 8192 + off;
            const float* cdp = cd + (b * 64) * 16 + h;
            float run[8];
#pragma unroll
            for (int i = 0; i < 8; ++i) run[i] = 0.f;
            u32x4 ra[8], rb[8]; float da[8], db[8];
#define SSD_LD(R, D, c0_) do { _Pragma("unroll") for (int i_ = 0; i_ < 8; ++i_) { R[i_] = *(const u32x4*)(S + (size_t)((c0_) + i_) * 16 * 8192); D[i_] = cdp[((c0_) + i_) * 16]; } } while (0)
#define SSD_RUN(R, D, c0_) do { _Pragma("unroll") for (int i_ = 0; i_ < 8; ++i_) { float v_[8]; unpack8(R[i_], v_); \
            u32x4 o_; o_.x = pk2(run[0], run[1]); o_.y = pk2(run[2], run[3]); o_.z = pk2(run[4], run[5]); o_.w = pk2(run[6], run[7]); \
            *(u32x4*)(S + (size_t)((c0_) + i_) * 16 * 8192) = o_; \
            _Pragma("unroll") for (int e_ = 0; e_ < 8; ++e_) run[e_] = D[i_] * run[e_] + v_[e_]; } } while (0)
            SSD_LD(ra, da, 0);
#pragma unroll 1
            for (int c0 = 0; c0 < 64; c0 += 16) {
                SSD_LD(rb, db, c0 + 8);
                SSD_RUN(ra, da, c0);
                if (c0 + 16 < 64) SSD_LD(ra, da, c0 + 16);
                SSD_RUN(rb, db, c0 + 8);
            }
#undef SSD_LD
#undef SSD_RUN
        }
    }
}

__device__ __forceinline__ void ssd_out_unit(const Params& P, LAS unsigned char* lds, int unit) {
    const int tid = threadIdx.x, lane = tid & 63, wave = __builtin_amdgcn_readfirstlane(tid >> 6), fr = lane & 15, fq = lane >> 4;
    const int gq = unit & 1, c = (unit >> 1) & 63, b = unit >> 7, tok0 = b * SEQ + c * 128;
    const bf16* xbc = (const bf16*)(P.ws + WS_XBC); const bf16* Z = (const bf16*)(P.ws + WS_Z);
    bf16* ycat = (bf16*)P.out;
    LAS bf16* Cs = (LAS bf16*)lds;
    LAS bf16* CBs = (LAS bf16*)(lds + 34816);
    LAS bf16* Bs = (LAS bf16*)(lds + 69632);
    LAS bf16* XdT = (LAS bf16*)(lds + 69632);
    LAS unsigned* XdT32 = (LAS unsigned*)(lds + 69632);
    LAS float* DT = (LAS float*)(lds + 139264);
    LAS float* AC = (LAS float*)(lds + 143360);
    LAS float* SS = (LAS float*)(lds + 147456);
    ssd_dt_acum(P, DT, AC, tok0, gq * 8 + wave, wave, lane);
#pragma unroll
    for (int r = 0; r < 8; ++r) { const int it = tid + 512 * r, row = (it >> 4) & 127, g16 = it & 15, isC = it >> 11;
        const u32x4 v = *(const u32x4*)(xbc + (size_t)(tok0 + row) * 1536 + 1024 + isC * 256 + gq * 128 + g16 * 8);
        *(LAS u32x4*)((isC ? Cs : Bs) + row * 136 + g16 * 8) = v; }
    __syncthreads();
    {
        bf16x8 cf[4];
#pragma unroll
        for (int ks = 0; ks < 4; ++ks) cf[ks] = *(const LAS bf16x8*)(Cs + (16 * wave + fr) * 136 + 32 * ks + 8 * fq);
#pragma unroll
        for (int st = 0; st < 8; ++st) { f32x4 a = {0.f, 0.f, 0.f, 0.f};
#pragma unroll
            for (int ks = 0; ks < 4; ++ks) { const bf16x8 bfr = *(const LAS bf16x8*)(Bs + (16 * st + fr) * 136 + 32 * ks + 8 * fq); a = MFMA16(bfr, cf[ks], a); }
            u32x2 o; o.x = pk2(a[0], a[1]); o.y = pk2(a[2], a[3]); *(LAS u32x2*)(CBs + (16 * wave + fr) * 136 + 16 * st + 4 * fq) = o; }
    }
    __syncthreads();
#pragma unroll 1
    for (int pass = 0; pass < 2; ++pass) {
        {
            const int hl = wave >> 1, hh = 4 * pass + hl, h = gq * 8 + hh; const float d0 = DT[hh * 128 + 2 * lane], d1 = DT[hh * 128 + 2 * lane + 1];
#pragma unroll
            for (int it = 0; it < 4; ++it) { const int pg = 4 * (wave & 1) + it;
                const bf16* xp = xbc + (size_t)(tok0 + 2 * lane) * 1536 + h * 64 + pg * 8; float x0[8], x1[8]; unpack8(*(const u32x4*)xp, x0); unpack8(*(const u32x4*)(xp + 1536), x1);
                LAS unsigned* d = XdT32 + hl * (64 * 68) + (pg * 8) * 68 + lane;
#pragma unroll
                for (int e = 0; e < 8; ++e) d[e * 68] = pk2(x0[e] * d0, x1[e] * d1); }
        }
        bf16x8 pf[4][4];
        { const int h_ = gq * 8 + 4 * pass + (wave >> 1); const bf16* S_ = (const bf16*)(P.ws + WS_SSDST) + ((size_t)((b * 64 + c) * 16 + h_)) * 8192;
#pragma unroll
          for (int pt = 0; pt < 4; ++pt)
#pragma unroll
              for (int ks = 0; ks < 4; ++ks) pf[pt][ks] = __builtin_bit_cast(bf16x8, *(const u32x4*)(S_ + (16 * pt + fr) * 128 + 32 * ks + 8 * fq)); }
        __syncthreads();
        {
            const int hl = wave >> 1, hh = 4 * pass + hl, h = gq * 8 + hh, rh = wave & 1;
            LAS bf16* Xh = XdT + hl * (64 * 136);
            u32x2 zn[4];
#pragma unroll
            for (int pt = 0; pt < 4; ++pt) zn[pt] = *(const u32x2*)(Z + (size_t)(tok0 + 64 * rh + fr) * 1024 + h * 64 + 16 * pt + 4 * fq);
            const float dsk = P.in[15][h];
#pragma unroll 1
            for (int lt = 0; lt < 4; ++lt) {
                const int l0 = 64 * rh + 16 * lt, l = l0 + fr;
                const float acl = AC[hh * 128 + l];
                f32x4 yd[4], yo[4]; u32x2 zc[4];
#pragma unroll
                for (int pt = 0; pt < 4; ++pt) { yd[pt] = (f32x4){0.f, 0.f, 0.f, 0.f}; yo[pt] = yd[pt]; zc[pt] = zn[pt];
                    if (lt < 3) zn[pt] = *(const u32x2*)(Z + (size_t)(tok0 + l + 16) * 1024 + h * 64 + 16 * pt + 4 * fq); }
#pragma unroll
                for (int i = 0; i < 4; ++i) {
                    if (32 * i <= l0 + 15) {
                        float cbv[8]; unpack8(*(const LAS u32x4*)(CBs + l * 136 + 32 * i + 8 * fq), cbv);
                        const f32x4 as0 = *(const LAS f32x4*)(AC + hh * 128 + 32 * i + 8 * fq), as1 = *(const LAS f32x4*)(AC + hh * 128 + 32 * i + 8 * fq + 4);
                        float mv[8];
#pragma unroll
                        for (int j = 0; j < 4; ++j) { const int s0 = 32 * i + 8 * fq + j;
                            mv[j] = l >= s0 ? cbv[j] * __expf(acl - as0[j]) : 0.f; mv[4 + j] = l >= s0 + 4 ? cbv[4 + j] * __expf(acl - as1[j]) : 0.f; }
                        u32x4 mw; mw.x = pk2(mv[0], mv[1]); mw.y = pk2(mv[2], mv[3]); mw.z = pk2(mv[4], mv[5]); mw.w = pk2(mv[6], mv[7]);
                        const bf16x8 mf = __builtin_bit_cast(bf16x8, mw);
#pragma unroll
                        for (int pt = 0; pt < 4; ++pt) { const bf16x8 xf = *(const LAS bf16x8*)(Xh + (16 * pt + fr) * 136 + 32 * i + 8 * fq); yd[pt] = MFMA16(xf, mf, yd[pt]); }
                    }
                }
#pragma unroll
                for (int ks = 0; ks < 4; ++ks) { const bf16x8 cfr = *(const LAS bf16x8*)(Cs + l * 136 + 32 * ks + 8 * fq);
#pragma unroll
                    for (int pt = 0; pt < 4; ++pt) yo[pt] = MFMA16(pf[pt][ks], cfr, yo[pt]); }
                const float el = __expf(acl), rdt = 1.f / DT[hh * 128 + l];
                float ssq = 0.f;
#pragma unroll
                for (int pt = 0; pt < 4; ++pt) { const int p0 = 16 * pt + 4 * fq, ch = h * 64 + p0;
                    const u32x2 zr = zc[pt]; const float zv[4] = {bflo(zr.x), bfhi(zr.x), bflo(zr.y), bfhi(zr.y)};
                    float y[4];
#pragma unroll
                    for (int j = 0; j < 4; ++j) { const float xv = bf2f(Xh[(p0 + j) * 136 + l]) * rdt; y[j] = (yd[pt][j] + el * yo[pt][j] + dsk * xv) * siluf(zv[j]); ssq += y[j] * y[j]; }
                    u32x2 o; o.x = pk2(y[0], y[1]); o.y = pk2(y[2], y[3]); *(u32x2*)(ycat + (size_t)(tok0 + l) * 2048 + ch) = o; }
                ssq += __shfl_xor(ssq, 16); ssq += __shfl_xor(ssq, 32);
                if (fq == 0) SS[hh * 128 + l] = ssq;
            }
        }
        __syncthreads();
    }
    {
        const float* ng = P.in[16];
#pragma unroll 8
        for (int r = 0; r < 16; ++r) { const int it = tid + 512 * r, row = it >> 6, g8 = it & 63, ch = gq * 512 + g8 * 8;
            float sq = 0.f;
#pragma unroll
            for (int q = 0; q < 8; ++q) sq += SS[q * 128 + row];
            const float rs = rsqrtf(sq * (1.f / 512.f) + EPS);
            bf16* yp = ycat + (size_t)(tok0 + row) * 2048 + ch; float v[8]; unpack8(*(const u32x4*)yp, v);
            const f32x4 g0 = *(const f32x4*)(ng + ch), g1 = *(const f32x4*)(ng + ch + 4);
            u32x4 o; o.x = pk2(v[0] * rs * g0[0], v[1] * rs * g0[1]); o.y = pk2(v[2] * rs * g0[2], v[3] * rs * g0[3]); o.z = pk2(v[4] * rs * g1[0], v[5] * rs * g1[1]); o.w = pk2(v[6] * rs * g1[2], v[7] * rs * g1[3]);
            *(u32x4*)yp = o; }
    }
    __syncthreads();
}

template <int PAT>
__device__ __forceinline__ void attn_phase(unsigned char* wsp, LAS unsigned char* lds) {
    constexpr int DIL = PAT == 0 ? 1 : (PAT == 1 ? 4 : 16), NB = 64 / DIL;
    const int tid = threadIdx.x, lane = tid & 63, wave = __builtin_amdgcn_readfirstlane(tid >> 6), fr = lane & 15, fq = lane >> 4;
    const bf16* QH = (const bf16*)(wsp + WS_QKV); const bf16* KH = QH + (size_t)3 * NTOK * 1024; const bf16* VH = KH + (size_t)NTOK * 1024;
    bf16* O = (bf16*)(wsp + WS_O); float* LSE = (float*)(wsp + WS_LSE);
    LAS bf16* Ks = (LAS bf16*)lds;
    LAS unsigned* Vs32 = (LAS unsigned*)(lds + 69632);
    LAS bf16* VsT = (LAS bf16*)(lds + 69632);
    u32x4 kreg[4], vreg[2][2];
#define ATT_LOAD(bh_, r_, nb_) do { \
        { const int key = tid >> 2, q4 = tid & 3; const bf16* kp = KH + ((size_t)(bh_) * 8192 + (size_t)((nb_) * 128 + key) * DIL + (r_)) * 128 + q4 * 32; \
          _Pragma("unroll") for (int i_ = 0; i_ < 4; ++i_) kreg[i_] = *(const u32x4*)(kp + i_ * 8); } \
        { const bf16* vp = VH + ((size_t)(bh_) * 8192 + (size_t)((nb_) * 128 + 2 * lane) * DIL + (r_)) * 128 + 16 * wave; \
          _Pragma("unroll") for (int g_ = 0; g_ < 2; ++g_) { vreg[g_][0] = *(const u32x4*)(vp + g_ * 8); vreg[g_][1] = *(const u32x4*)(vp + (size_t)DIL * 128 + g_ * 8); } } } while (0)
#define ATT_ZERO() do { _Pragma("unroll") for (int i_ = 0; i_ < 4; ++i_) kreg[i_] = (u32x4){0u, 0u, 0u, 0u}; \
        _Pragma("unroll") for (int g_ = 0; g_ < 2; ++g_) { vreg[g_][0] = (u32x4){0u, 0u, 0u, 0u}; vreg[g_][1] = vreg[g_][0]; } } while (0)
#define ATT_STORE(slot_) do { \
        { const int key = tid >> 2, q4 = tid & 3; _Pragma("unroll") for (int i_ = 0; i_ < 4; ++i_) *(LAS u32x4*)(Ks + ((slot_) * 128 + key) * 136 + q4 * 32 + i_ * 8) = kreg[i_]; } \
        { const int sp = (slot_) * 64 + (kperm(2 * lane) >> 1); \
          _Pragma("unroll") for (int g_ = 0; g_ < 2; ++g_) { const u32x4 a_ = vreg[g_][0], c_ = vreg[g_][1]; LAS unsigned* vd = Vs32 + (16 * wave + 8 * g_) * 132 + sp; \
            vd[0] = pair_lo(a_.x, c_.x); vd[132] = pair_hi(a_.x, c_.x); vd[2 * 132] = pair_lo(a_.y, c_.y); vd[3 * 132] = pair_hi(a_.y, c_.y); \
            vd[4 * 132] = pair_lo(a_.z, c_.z); vd[5 * 132] = pair_hi(a_.z, c_.z); vd[6 * 132] = pair_lo(a_.w, c_.w); vd[7 * 132] = pair_hi(a_.w, c_.w); } } } while (0)
#pragma unroll 1
    for (int u0 = blockIdx.x * 8; u0 < 2048; u0 += gridDim.x * 8)
#pragma unroll 1
    for (int i = 0; i < 8; ++i) {
        const int unit = u0 + i, nblk = unit % NB, r = (unit / NB) % DIL, h = (unit >> 6) & 7, b = unit >> 9, bh = b * 8 + h;
        const int cs = i & 1, ps = cs ^ 1;
        const bool chain_start = (i == 0) || (nblk == 0);
        if (chain_start) {
            if (nblk > 0) ATT_LOAD(bh, r, nblk - 1); else ATT_ZERO();
            ATT_STORE(ps);
            ATT_LOAD(bh, r, nblk);
        }
        ATT_STORE(cs);
        const int qi = 16 * wave + fr;
        const size_t qpos = (size_t)(nblk * 128 + qi) * DIL + r;
        bf16x8 qf[4];
#pragma unroll
        for (int ks = 0; ks < 4; ++ks) qf[ks] = __builtin_bit_cast(bf16x8, *(const u32x4*)(QH + (((size_t)(PAT * 4 + b) * 8 + h) * 8192 + qpos) * 128 + 32 * ks + 8 * fq));
        const size_t qtok = (size_t)b * SEQ + qpos;
        bf16* op = O + qtok * 1024 + h * 128 + 4 * fq; float* lp = LSE + qtok * 8 + h;
        u32x2 pv[8]; float lprev = 0.f;
        if (PAT != 0) { lprev = *lp;
#pragma unroll
            for (int nt = 0; nt < 8; ++nt) pv[nt] = *(const u32x2*)(op + 16 * nt); }
        __syncthreads();
        { const int un = unit + 1, nb2 = un % NB; if (i < 7 && nb2 != 0) ATT_LOAD(bh, r, nb2); }
        const int kj0 = 16 * (wave & ~1);
        f32x4 sc[10];
        float mx = -1e30f;
#pragma unroll
        for (int t = 0; t < 10; ++t) { f32x4 a = {0.f, 0.f, 0.f, 0.f};
            const int kjt = kj0 + 16 * t, krow = ((kjt >> 7) ? cs : ps) * 128 + (kjt & 127) + fr;
#pragma unroll
            for (int ks = 0; ks < 4; ++ks) { const bf16x8 kf = *(const LAS bf16x8*)(Ks + krow * 136 + 32 * ks + 8 * fq); a = MFMA16(kf, qf[ks], a); }
#pragma unroll
            for (int j = 0; j < 4; ++j) { const int kj = kjt + 4 * fq + j; const bool ok = (kj >= qi) && (kj <= qi + 128) && (nblk > 0 || kj >= 128);
                a[j] = ok ? a[j] * 0.08838834764831845f : -1e30f; mx = fmaxf(mx, a[j]); }
            sc[t] = a; }
        mx = fmaxf(mx, __shfl_xor(mx, 16)); mx = fmaxf(mx, __shfl_xor(mx, 32));
        float sum = 0.f;
#pragma unroll
        for (int t = 0; t < 10; ++t)
#pragma unroll
            for (int j = 0; j < 4; ++j) { const float pv = __expf(sc[t][j] - mx); sc[t][j] = pv; sum += pv; }
        sum += __shfl_xor(sum, 16); sum += __shfl_xor(sum, 32);
        const float lse = mx + __logf(sum);
        f32x4 o[8];
#pragma unroll
        for (int nt = 0; nt < 8; ++nt) o[nt] = (f32x4){0.f, 0.f, 0.f, 0.f};
#pragma unroll
        for (int g = 0; g < 5; ++g) { u32x4 pw; pw.x = pk2(sc[2 * g][0], sc[2 * g][1]); pw.y = pk2(sc[2 * g][2], sc[2 * g][3]); pw.z = pk2(sc[2 * g + 1][0], sc[2 * g + 1][1]); pw.w = pk2(sc[2 * g + 1][2], sc[2 * g + 1][3]);
            const bf16x8 pf = __builtin_bit_cast(bf16x8, pw);
            const int kjg = kj0 + 32 * g, kcol = ((kjg >> 7) ? cs : ps) * 128 + (kjg & 127) + 8 * fq;
#pragma unroll
            for (int nt = 0; nt < 8; ++nt) { const bf16x8 vf = *(const LAS bf16x8*)(VsT + (16 * nt + fr) * 264 + kcol); o[nt] = MFMA16(vf, pf, o[nt]); } }
        {
            if (PAT == 0) {
                const float inv = 1.f / sum;
#pragma unroll
                for (int nt = 0; nt < 8; ++nt) { u32x2 w; w.x = pk2(o[nt][0] * inv, o[nt][1] * inv); w.y = pk2(o[nt][2] * inv, o[nt][3] * inv); *(u32x2*)(op + 16 * nt) = w; }
                if (fq == 0) *lp = lse;
            } else {
                const float m2 = fmaxf(lprev, lse), nl = m2 + __logf(__expf(lprev - m2) + __expf(lse - m2));
                const float w1 = __expf(lprev - nl), w2 = __expf(lse - nl) / sum;
#pragma unroll
                for (int nt = 0; nt < 8; ++nt) { u32x2 w; w.x = pk2(w1 * bflo(pv[nt].x) + w2 * o[nt][0], w1 * bfhi(pv[nt].x) + w2 * o[nt][1]); w.y = pk2(w1 * bflo(pv[nt].y) + w2 * o[nt][2], w1 * bfhi(pv[nt].y) + w2 * o[nt][3]);
                    *(u32x2*)(op + 16 * nt) = w; }
                if (PAT == 1 && fq == 0) *lp = nl;
            }
        }
        __syncthreads();
    }
#undef ATT_LOAD
#undef ATT_ZERO
#undef ATT_STORE
}

#define XB_TMO      128
#define XB_XCNT(j)  (256  + 64 * (j))
#define XB_XSUB(j)  (1280 + 64 * (j))
#define XB_XGEN(j)  (2304 + 64 * (j))
#define XB_TOP      3328
#define XB_TOPGEN   3392
#define XCD_BAR_WORDS 3456
#define XB_SPIN_CAP (1u << 18)

__device__ __forceinline__ unsigned xb_ld(unsigned* p)              { return __hip_atomic_load(p, __ATOMIC_RELAXED, __HIP_MEMORY_SCOPE_AGENT); }
__device__ __forceinline__ unsigned xb_add(unsigned* p, unsigned v) { return __hip_atomic_fetch_add(p, v, __ATOMIC_RELAXED, __HIP_MEMORY_SCOPE_AGENT); }
__device__ __forceinline__ unsigned xb_xcc_id() { return (unsigned)__builtin_amdgcn_s_getreg((3 << 11) | 20) & 0xFu; }
#define XB_SPIN(cond, bar) do { unsigned _sp = 0; while (cond) { __builtin_amdgcn_s_sleep(1); \
    if ((++_sp & 255u) == 0u) { if (xb_ld(&(bar)[XB_TMO])) break; if (_sp > XB_SPIN_CAP) { atomicAdd(&(bar)[XB_TMO], 1u); break; } } } } while (0)

struct XcdBarrier {
    unsigned* bar; unsigned x;
    volatile LAS unsigned* st;
};

__device__ __forceinline__ XcdBarrier xcd_barrier_post(unsigned* bar, volatile LAS unsigned* st) {
    XcdBarrier b; b.bar = bar; b.x = xb_xcc_id(); b.st = st;
    if (threadIdx.x == 0) (void)xb_add(&bar[XB_XCNT(b.x)], 1u);
    return b;
}
__device__ __forceinline__ void xcd_barrier_complete(unsigned* bar, unsigned x, unsigned& nloc, unsigned& nx) {
    const unsigned G = gridDim.x * gridDim.y * gridDim.z;
    unsigned sum, cnt, mine, sp = 0u;
    for (;;) {
        sum = 0u; cnt = 0u; mine = 0u;
#pragma unroll
        for (unsigned j = 0; j < 16; ++j) { const unsigned c = xb_ld(&bar[XB_XCNT(j)]); sum += c; cnt += (c > 0u) ? 1u : 0u; mine = (j == x) ? c : mine; }
        if (sum == G) break;
        __builtin_amdgcn_s_sleep(1);
        if ((++sp & 255u) == 0u) { if (xb_ld(&bar[XB_TMO])) break; if (sp > XB_SPIN_CAP) { atomicAdd(&bar[XB_TMO], 1u); break; } }
    }
    nloc = mine > 0u ? mine : 1u; nx = cnt > 0u ? cnt : 1u;
}

__device__ __forceinline__ void xcd_barrier(const XcdBarrier& b) {
    asm volatile("s_waitcnt vmcnt(0)" ::: "memory");
    __syncthreads();
    if (threadIdx.x == 0) {
        unsigned* bar = b.bar;
        __builtin_amdgcn_s_waitcnt(0);
        unsigned nloc = b.st[0], nx = b.st[1];
        if (nloc == 0u) { xcd_barrier_complete(bar, b.x, nloc, nx); b.st[0] = nloc; b.st[1] = nx; }
        const unsigned old = xb_add(&bar[XB_XSUB(b.x)], 1u);
        const unsigned gen = old / nloc;
        if (old + 1u == (gen + 1u) * nloc) {
            __builtin_amdgcn_fence(__ATOMIC_RELEASE, "agent");
            asm volatile("s_waitcnt vmcnt(0)" ::: "memory");
            const unsigned og = xb_add(&bar[XB_TOP], 1u);
            const unsigned tg = og / nx;
            if (og + 1u == (tg + 1u) * nx) xb_add(&bar[XB_TOPGEN], 1u);
            else XB_SPIN(xb_ld(&bar[XB_TOPGEN]) == tg, bar);
            __builtin_amdgcn_fence(__ATOMIC_ACQUIRE, "agent");
            xb_add(&bar[XB_XGEN(b.x)], 1u);
            asm volatile("s_waitcnt vmcnt(0)" ::: "memory");
        } else {
            XB_SPIN(xb_ld(&bar[XB_XGEN(b.x)]) == gen, bar);
            __builtin_amdgcn_fence(__ATOMIC_ACQUIRE, "agent");
            asm volatile("s_waitcnt vmcnt(0)" ::: "memory");
        }
    }
    __syncthreads();
}

typedef const Params __attribute__((address_space(4)))* KParamsPtr;
__device__ __forceinline__ KParamsPtr kp_launder(KParamsPtr p) { asm volatile("" : "+s"(p)); return p; }
#define LOADP() Params P; __builtin_memcpy(&P, kp_launder(kp0), sizeof(Params)); unsigned char* ws = P.ws; const float* mod = (const float*)(ws + WS_MOD); (void)mod
__global__ void __launch_bounds__(512) trunk_fwd(Params Pk) {
    KParamsPtr kp0 = (KParamsPtr)__builtin_amdgcn_kernarg_segment_ptr();
    extern __shared__ __attribute__((aligned(16))) unsigned char lds_raw[];
    LAS unsigned char* lds = (LAS unsigned char*)lds_raw;
    volatile LAS unsigned* bst = (volatile LAS unsigned*)(lds + LDS_BYTES - 64);
    if (threadIdx.x < 2) bst[threadIdx.x] = 0u;
    __syncthreads();
    (void)xcd_barrier_post((unsigned*)(Pk.ws + WS_BAR) + Pk.li * 4096, bst);
#define GRID_BAR() do { XcdBarrier xb_; { Params Pb; __builtin_memcpy(&Pb, kp_launder(kp0), sizeof(Params)); xb_.bar = (unsigned*)(Pb.ws + WS_BAR) + Pb.li * 4096; } xb_.x = xb_xcc_id(); xb_.st = (volatile LAS unsigned*)(lds + LDS_BYTES - 64); xcd_barrier(xb_); } while (0)
    const int lo = Pk.ph_lo, hi = Pk.ph_hi, G = gridDim.x, bx = blockIdx.x;
#define IN(k) (lo <= (k) && (k) < hi)
#define SEAM(k) do { if (IN(k) && IN((k) + 1)) { GRID_BAR(); } } while (0)
#define REPB(k) _Pragma("unroll 1") for (int rep = 0; rep < REP[k]; ++rep) { if (rep) GRID_BAR();
#define REPE }
    using namespace pg8;
    if (IN(0)) { LOADP(); REPB(0)
    phase_prologue(P, lds);
    REPE }
    SEAM(0);
    if (IN(1)) { LOADP(); REPB(1)
    phase_norm<0, 0, 0>(P, lds, P.in[0], nullptr, nullptr, nullptr, P.in[4], mod + 1024, mod);
    REPE }
    SEAM(1);
    if (IN(2)) { LOADP(); REPB(2)
    { Gemm g{(const bf16*)(ws + WS_H), (const bf16*)(ws + WS_WHYBIN), 1024, 1024, 1024}; StaticOrder S; S.init(NTOK, 3584, G, bx);
            EpiHybIn E{(bf16*)(ws + WS_Z), (bf16*)P.out, (bf16*)(ws + WS_UG)}; gemm_phase(lds, g, S, E); }
    REPE }
    SEAM(2);
    if (IN(3)) { LOADP(); REPB(3)
        phase_conv(P);
    REPE }
    SEAM(3);
    if (IN(4)) { LOADP(); REPB(4)
    {
            for (int u = bx; u < 512; u += G) ssd_local_unit(P, lds, u);
            Gemm g{(const bf16*)(ws + WS_UG), (const bf16*)(ws + WS_BPOW), 384, 256, 256}; GroupOrder S{G, bx}; EpiS5State E{(float*)(ws + WS_HLOC)}; gemm_phase(lds, g, S, E); }
    REPE }
    SEAM(4);
    if (IN(5)) { LOADP(); REPB(5)
    phase_scans(P);
    REPE }
    SEAM(5);
    if (IN(6)) { LOADP(); REPB(6)
    {
            for (int u = bx; u < 512; u += G) ssd_out_unit(P, lds, u);
            Gemm g{(const bf16*)(ws + WS_UG), (const bf16*)(ws + WS_TOEC), 384, 384, 384}; GroupOrder S{G, bx}; EpiS5Y E{(const bf16*)(ws + WS_UG), P.in[24], (bf16*)(ws + WS_S5Y)}; gemm_phase(lds, g, S, E); }
    REPE }
    SEAM(6);
    if (IN(7)) { LOADP(); REPB(7)
    { Gemm g{(const bf16*)(ws + WS_S5Y), (const bf16*)(ws + WS_WGLU), 1024, 1024, 1024}; StaticOrder S; S.init(NTOK, 1024, G, bx);
            EpiGlu E{(const bf16*)(ws + WS_S5Y), P.in[26], (bf16*)P.out}; gemm_phase(lds, g, S, E); }
    REPE }
    SEAM(7);
    if (IN(8)) { LOADP(); REPB(8)
    { Gemm g{(const bf16*)P.out, (const bf16*)(ws + WS_WHYBOUT), 2048, 2048, 2048}; StaticOrder S; S.init(NTOK, 1024, G, bx);
            EpiPlain E{(bf16*)(ws + WS_Y), 1024}; gemm_phase(lds, g, S, E); }
    REPE }
    SEAM(8);
    if (IN(9)) { LOADP(); REPB(9)
    phase_norm<1, 0, 1>(P, lds, P.in[0], P.out, P.in[5], mod + 2048, P.in[6], mod + 4096, mod + 3072);
    REPE }
    SEAM(9);
    if (IN(10)) { LOADP(); REPB(10)
    { Gemm g{(const bf16*)(ws + WS_H), (const bf16*)(ws + WS_WFFIN), 1024, 1024, 1024}; StaticOrder S; S.init(NTOK, 5632, G, bx);
            EpiSwiglu E{(bf16*)(ws + WS_HID)}; gemm_phase(lds, g, S, E); }
    REPE }
    SEAM(10);
    if (IN(11)) { LOADP(); REPB(11)
    { Gemm g{(const bf16*)(ws + WS_HID), (const bf16*)(ws + WS_WFFOUT), 2816, 2816, 2816}; StaticOrder S; S.init(NTOK, 1024, G, bx);
            EpiPlain E{(bf16*)(ws + WS_Y), 1024}; gemm_phase(lds, g, S, E); }
    REPE }
    SEAM(11);
    if (IN(12)) { LOADP(); REPB(12)
    phase_norm<1, 1, 1>(P, lds, P.out, P.out, P.in[7], mod + 5120, P.in[4] + 1024, mod + 4 * 6144 + 1024, mod + 4 * 6144);
    REPE }
    SEAM(12);
    if (IN(13)) { LOADP(); REPB(13)
    { Gemm g{(const bf16*)(ws + WS_H), (const bf16*)(ws + WS_WQKV), 1024, 1024, 1024}; StaticOrder S; S.init(NTOK, 5120, G, bx);
            EpiQKV E{(bf16*)(ws + WS_QKV)}; gemm_phase(lds, g, S, E); }
    REPE }
    SEAM(13);
    if (IN(14)) { LOADP(); REPB(14)
    attn_phase<0>(ws, lds);
    REPE }
    SEAM(14);
    if (IN(15)) { LOADP(); REPB(15)
    attn_phase<1>(ws, lds);
    REPE }
    SEAM(15);
    if (IN(16)) { LOADP(); REPB(16)
    attn_phase<2>(ws, lds);
    REPE }
    SEAM(16);
    if (IN(17)) { LOADP(); REPB(17)
    { Gemm g{(const bf16*)(ws + WS_O), (const bf16*)(ws + WS_WO), 1024, 1024, 1024}; StaticOrder S; S.init(NTOK, 1024, G, bx);
            EpiPlain E{(bf16*)(ws + WS_Y), 1024}; gemm_phase(lds, g, S, E); }
    REPE }
    SEAM(17);
    if (IN(18)) { LOADP(); REPB(18)
    phase_norm<1, 1, 1>(P, lds, P.out, ws + WS_XB2, P.in[5] + 1024, mod + 4 * 6144 + 2048, P.in[6] + 1024, mod + 4 * 6144 + 4096, mod + 4 * 6144 + 3072);
    REPE }
    SEAM(18);
    if (IN(19)) { LOADP(); REPB(19)
    { Gemm g{(const bf16*)(ws + WS_H), (const bf16*)(ws + WS_WFFIN) + (size_t)5632 * 1024, 1024, 1024, 1024}; StaticOrder S; S.init(NTOK, 5632, G, bx);
            EpiSwiglu E{(bf16*)(ws + WS_HID)}; gemm_phase(lds, g, S, E); }
    REPE }
    SEAM(19);
    if (IN(20)) { LOADP(); REPB(20)
    { Gemm g{(const bf16*)(ws + WS_HID), (const bf16*)(ws + WS_WFFOUT) + (size_t)1024 * 2816, 2816, 2816, 2816}; StaticOrder S; S.init(NTOK, 1024, G, bx);
            EpiPlain E{(bf16*)(ws + WS_Y), 1024}; gemm_phase(lds, g, S, E); }
    REPE }
    SEAM(20);
    if (IN(21)) { LOADP(); REPB(21)
    phase_norm<2, 1, 0>(P, lds, ws + WS_XB2, P.out, P.in[7] + 1024, mod + 4 * 6144 + 5120, nullptr, nullptr, nullptr);
    REPE }
#undef IN
#undef SEAM
}

extern "C" void kernel_launch(void* const* d_in, const int* in_sizes, int n_in, void* d_out, int out_size, void* d_ws, size_t ws_size, hipStream_t stream) {
    static int grid = 0;
    if (grid == 0) {
        if (n_in != 30 || out_size != NTOK * DM || ws_size < WS_END) { fprintf(stderr, "kernel_launch: unexpected shapes (n_in %d out %d ws %zu)\n", n_in, out_size, ws_size); grid = -1; return; }
        int dev = 0, cus = 0, per_cu = 0;
        hipGetDevice(&dev); hipDeviceGetAttribute(&cus, hipDeviceAttributeMultiprocessorCount, dev);
        if (hipFuncSetAttribute((const void*)trunk_fwd, hipFuncAttributeMaxDynamicSharedMemorySize, LDS_BYTES) != hipSuccess) { fprintf(stderr, "kernel_launch: hipFuncSetAttribute failed\n"); grid = -1; return; }
        if (hipOccupancyMaxActiveBlocksPerMultiprocessor(&per_cu, (const void*)trunk_fwd, 512, LDS_BYTES) != hipSuccess || per_cu < 1) { fprintf(stderr, "kernel_launch: occupancy query says %d\n", per_cu); per_cu = 1; }
        (void)hipGetLastError();
        grid = cus;
        if (grid > cus * per_cu) grid = cus * per_cu;
        if (grid != 256) { fprintf(stderr, "kernel_launch: this build's phase bodies assume a 256-workgroup grid (256 CUs); got %d; nothing launched\n", grid); grid = -1; return; }
    }
    if (grid < 0) return;
    hipMemsetAsync(d_ws, 0, 1 * MiB, stream);
    Params p{};
    for (int i = 0; i < 30; ++i) p.in[i] = (const float*)d_in[i];
    p.out = (float*)d_out; p.ws = (unsigned char*)d_ws;
    static const int launches[] = {LAUNCH_LIST};
    for (unsigned li = 0; li + 1 < sizeof(launches) / sizeof(int); li += 2) { p.ph_lo = launches[li]; p.ph_hi = launches[li + 1]; p.li = (int)(li / 2); void* args[] = {&p};
        hipError_t e = hipLaunchCooperativeKernel((void*)trunk_fwd, dim3(grid), dim3(512), args, LDS_BYTES, stream);
        if (e != hipSuccess) { fprintf(stderr, "cooperative launch failed: %s (grid %d)\n", hipGetErrorString(e), grid); break; } }
}
```

```cpp
#include <hip/hip_runtime.h>
#include <hip/hip_cooperative_groups.h>
#include <cstdio>
#include <cstdint>
namespace cg = cooperative_groups;

#define LAS __attribute__((address_space(3)))
typedef unsigned short bf16;
typedef short bf16x8 __attribute__((ext_vector_type(8)));
typedef float f32x4 __attribute__((ext_vector_type(4)));
typedef unsigned u32x4 __attribute__((ext_vector_type(4)));
typedef unsigned u32x2 __attribute__((ext_vector_type(2)));

#ifndef N_LAUNCH_PER_PHASE
#define N_LAUNCH_PER_PHASE 0
#endif

constexpr int NTOK = 32768, DM = 1024, SEQ = 8192, NPH = 22;
constexpr float EPS = 1e-6f;
constexpr size_t MiB = 1u << 20;
constexpr size_t WS_MOD = 0;
constexpr size_t WS_A16 = 256 * 1024;
constexpr size_t WS_CD = 320 * 1024;
constexpr size_t WS_BAR = 512 * 1024;
constexpr size_t WS_LSE = 1 * MiB;
constexpr size_t WS_WHYBIN = 2 * MiB, WS_WGLU = 9 * MiB, WS_WHYBOUT = 11 * MiB, WS_WFFIN = 15 * MiB, WS_WFFOUT = 37 * MiB,
                 WS_WQKV = 48 * MiB, WS_WO = 58 * MiB, WS_TOEC = 60 * MiB, WS_BPOW = 72 * MiB, WS_DTRAW = 80 * MiB;
constexpr size_t WS_H = 84 * MiB, WS_Y = 148 * MiB, WS_BIG = 212 * MiB;
constexpr size_t WS_Z = WS_BIG;
constexpr size_t WS_XBC = WS_BIG + 64 * MiB;
constexpr size_t WS_UG = WS_BIG + 160 * MiB;
constexpr size_t WS_HID = WS_BIG;
constexpr size_t WS_QKV = 192 * MiB;
constexpr size_t WS_SSDST = WS_H;
constexpr size_t WS_HLOC = WS_Y;
constexpr size_t WS_S5Y = WS_Y;
constexpr size_t WS_O = WS_H;
constexpr size_t WS_XB2 = 388 * MiB;
constexpr size_t WS_END = 512 * MiB;
constexpr int LDS_BYTES = 155648;
#ifndef LAUNCH_LIST
#define LAUNCH_LIST 0, NPH
#endif
#ifndef REP_LIST
#define REP_LIST 1,1,1,1,1,1,1,1,1,1,1,1,1,1,1,1,1,1,1,1,1,1
#endif
constexpr int REP[22] = {REP_LIST};

struct Params { const float* in[30]; float* out; unsigned char* ws; int ph_lo, ph_hi, li, pad; };

__device__ __forceinline__ unsigned f2bf(float f) { unsigned u = __builtin_bit_cast(unsigned, f); return (u + 0x7fffu + ((u >> 16) & 1u)) >> 16; }
typedef __bf16 bf16x2_t __attribute__((ext_vector_type(2)));
typedef float f32x2_t __attribute__((ext_vector_type(2)));
__device__ __forceinline__ unsigned pk2(float lo, float hi) { const f32x2_t v = {lo, hi}; return __builtin_bit_cast(unsigned, __builtin_convertvector(v, bf16x2_t)); }
__device__ __forceinline__ float bf2f(unsigned b) { return __builtin_bit_cast(float, b << 16); }
__device__ __forceinline__ float bflo(unsigned w) { return __builtin_bit_cast(float, w << 16); }
__device__ __forceinline__ float bfhi(unsigned w) { return __builtin_bit_cast(float, w & 0xffff0000u); }
__device__ __forceinline__ void unpack8(u32x4 r, float* v) { v[0] = bflo(r.x); v[1] = bfhi(r.x); v[2] = bflo(r.y); v[3] = bfhi(r.y); v[4] = bflo(r.z); v[5] = bfhi(r.z); v[6] = bflo(r.w); v[7] = bfhi(r.w); }
__device__ __forceinline__ float wave_sum(float v) {
#pragma unroll
    for (int o = 1; o < 64; o <<= 1) v += __shfl_xor(v, o);
    return v;
}
__device__ __forceinline__ float siluf(float x) { return x * __builtin_amdgcn_rcpf(1.f + __expf(-x)); }
__device__ __forceinline__ float sigmf(float x) { return __builtin_amdgcn_rcpf(1.f + __expf(-x)); }
__device__ __forceinline__ int kperm(int k) { return (k & ~31) | (((k >> 2) & 3) << 3) | (((k >> 4) & 1) << 2) | (k & 3); }
__device__ __forceinline__ float gelu_erf(float v) {
    const float av = fabsf(v), t = __builtin_amdgcn_rcpf(av * 0.2316418882f + 1.0f);
    float q = t * 0.5307027145f + (-0.7265760135f); q = q * t + 0.7107068705f; q = q * t + (-0.142248368f); q = q * t + 0.127414796f; q = q * t;
    const float e = __builtin_amdgcn_exp2f((v * v) * (-0.72134752044f));
    const float m = v * (q * e);
    return v < 0.f ? m : v - m;
}
#define LDS_WAIT() asm volatile("s_waitcnt lgkmcnt(0)" ::: "memory")
#define WAVE_SYNC() do { asm volatile("s_waitcnt lgkmcnt(0)" ::: "memory"); __builtin_amdgcn_wave_barrier(); } while (0)
#define MFMA16(a, b, c) __builtin_amdgcn_mfma_f32_16x16x32_bf16((a), (b), (c), 0, 0, 0)

namespace pg8 {
constexpr int BM = 256, BK = 64, HALF = 128, HTB = HALF * BK * 2, STAGE_BYTES = 8 * HTB, NXCD = 8, WGM = 8;
__device__ __forceinline__ int lds_byte(int r, int c) { const int st = (r >> 4) * 2 + (c >> 5), rr = r & 15, cc = c & 31, ob = rr * 64 + cc * 2; return st * 1024 + (ob ^ (((ob >> 9) & 1) << 5)); }
__device__ __forceinline__ void stage_rc(int b, int& R, int& C) { const int st = b / 1024, sb = b % 1024, swz = sb ^ (((sb >> 9) & 1) << 5); R = (st >> 1) * 16 + swz / 64; C = (st & 1) * 32 + (swz % 64) / 2; }
__device__ __forceinline__ int perm32(int rho) { const int n = rho >> 4, i = rho & 15; return 8 * (i >> 2) + 4 * n + (i & 3); }

struct Unit { int pm, pn, pb; };
struct Gemm { const bf16* A; const bf16* Bt; int lda, ldb, K; };

struct StaticOrder {
    int nM, nN, nwg, G, c;
    __device__ void init(int M, int N, int G_, int c_) { nM = M / BM; nN = N / BM; nwg = nM * nN; G = G_; c = c_; }
    __device__ bool next(int i, Unit& u) const {
        const long L = (long)i * G + c; if (L >= nwg) return false;
        int wgid = (int)L; { const int q = nwg / NXCD, r = nwg % NXCD, xcd = wgid % NXCD, off = wgid / NXCD; wgid = (xcd < r ? xcd * (q + 1) : r * (q + 1) + (xcd - r) * q) + off; }
        const int nig = WGM * nN, gid = wgid / nig, fm = gid * WGM, gsz = (nM - fm) < WGM ? (nM - fm) : WGM;
        u.pm = fm + ((wgid % nig) % gsz); u.pn = (wgid % nig) / gsz; u.pb = u.pn; return true;
    }
};
struct GroupOrder {
    int G, c;
    __device__ bool next(int i, Unit& u) const { const int L = i * G + c; if (L >= 512) return false; u.pm = L; u.pn = 0; u.pb = L >> 3; return true; }
};

template <class Epi, class Sched>
__device__ __forceinline__ void gemm_phase(LAS unsigned char* lds, const Gemm g, const Sched& S, const Epi& E) {
    const int tid = threadIdx.x, wid = __builtin_amdgcn_readfirstlane(tid >> 6), lane = tid & 63, wr = wid >> 2, wc = wid & 3, fr = lane & 15, fq = lane >> 4;
    const int K = g.K, nt = K / BK;
    unsigned voffA[2], voffB[2];
#pragma unroll
    for (int i = 0; i < 2; ++i) { int R, C; stage_rc(tid * 16 + i * 8192, R, C); const int Rb = (R & ~31) + perm32(R & 31);
        voffA[i] = (unsigned)(R * g.lda + C) * 2u; voffB[i] = (unsigned)(Rb * g.ldb + C) * 2u; }
    const size_t kstep = (size_t)(BK * 2);
    const size_t hA = (size_t)HALF * g.lda * 2, hB = (size_t)HALF * g.ldb * 2, tA = 2 * hA, tB = 2 * hB;
    const unsigned ldsw = (unsigned)wid * 1024u;
    const int aoff = lds_byte(wr * 64 + fr, fq * 8), boff = lds_byte(wc * 32 + fr, fq * 8);
#define PG8_SA(b, h) (((b) * 2 + (h)) * HTB)
#define PG8_SB(b, h) ((4 + (b) * 2 + (h)) * HTB)
#define PG8_STAGE(bufoff, gbase, voff) do { _Pragma("unroll") for (int _i = 0; _i < 2; ++_i) \
        __builtin_amdgcn_global_load_lds((const unsigned*)((const char*)(gbase) + (voff)[_i]), (LAS unsigned*)(lds + (bufoff) + ldsw + _i * 8192), 16, 0, 0); } while (0)
#define PG8_LDA(dst, b, h) do { _Pragma("unroll") for (int m = 0; m < 4; ++m) _Pragma("unroll") for (int k = 0; k < 2; ++k) dst[m][k] = *(const LAS bf16x8*)(lds + PG8_SA(b, h) + aoff + m * 2048 + k * 1024); } while (0)
#define PG8_LDB(dst, b, h) do { _Pragma("unroll") for (int n = 0; n < 2; ++n) _Pragma("unroll") for (int k = 0; k < 2; ++k) dst[n][k] = *(const LAS bf16x8*)(lds + PG8_SB(b, h) + boff + n * 2048 + k * 1024); } while (0)
#define PG8_MMA(ai, bj, At, Bt) do { __builtin_amdgcn_s_setprio(1); _Pragma("unroll") for (int m = 0; m < 4; ++m) _Pragma("unroll") for (int n = 0; n < 2; ++n) _Pragma("unroll") for (int k = 0; k < 2; ++k) \
        acc[ai][bj][m][n] = __builtin_amdgcn_mfma_f32_16x16x32_bf16(Bt[n][k], At[m][k], acc[ai][bj][m][n], 0, 0, 0); __builtin_amdgcn_s_setprio(0); } while (0)
#define PG8_WAIT_V(n) asm volatile("s_waitcnt vmcnt(" #n ")" ::: "memory")
#define PG8_WAIT_L(n) asm volatile("s_waitcnt lgkmcnt(" #n ")" ::: "memory")
#define PG8_BAR __builtin_amdgcn_s_barrier()
#define PG8_SCHED __builtin_amdgcn_sched_barrier(0)
    Unit cur, nxt; int ui = 0;
    if (!S.next(0, cur)) return;
    f32x4 acc[2][2][4][2];
#pragma unroll
    for (int a = 0; a < 2; ++a)
#pragma unroll
        for (int b = 0; b < 2; ++b)
#pragma unroll
            for (int m = 0; m < 4; ++m)
#pragma unroll
                for (int n = 0; n < 2; ++n) acc[a][b][m][n] = (f32x4){0.f, 0.f, 0.f, 0.f};
    bf16x8 At[4][2], B0[2][2], B1[2][2];
    const char* cA = (const char*)g.A + (size_t)cur.pm * tA; const char* cB = (const char*)g.Bt + (size_t)cur.pb * tB;
    {
        PG8_STAGE(PG8_SB(0, 0), cB, voffB); PG8_STAGE(PG8_SB(0, 1), cB + hB, voffB); PG8_STAGE(PG8_SA(0, 0), cA, voffA); PG8_STAGE(PG8_SA(0, 1), cA + hA, voffA);
        if (wr == 1) PG8_BAR;
        PG8_WAIT_V(2); PG8_BAR;
        PG8_STAGE(PG8_SB(1, 0), cB + kstep, voffB); PG8_STAGE(PG8_SA(1, 0), cA + kstep, voffA); PG8_STAGE(PG8_SB(1, 1), cB + hB + kstep, voffB);
        PG8_WAIT_V(6); PG8_BAR;
    }
    for (;;) {
        const bool has_next = S.next(ui + 1, nxt);
        const char* nA = has_next ? (const char*)g.A + (size_t)nxt.pm * tA : cA; const char* nB = has_next ? (const char*)g.Bt + (size_t)nxt.pb * tB : cB;
#pragma unroll 1
        for (int t = 0; t < nt; t += 2) {
            const bool last = (t == nt - 2);
            const char* a1 = cA + (size_t)(t + 1) * kstep;
            const char* a2 = last ? nA : cA + (size_t)(t + 2) * kstep; const char* b2 = last ? nB : cB + (size_t)(t + 2) * kstep;
            const char* a3 = a2 + kstep; const char* b3 = b2 + kstep;
            PG8_LDB(B0, 0, 0); PG8_LDB(B1, 0, 1); PG8_SCHED; PG8_LDA(At, 0, 0); PG8_STAGE(PG8_SA(1, 1), a1 + hA, voffA);
            PG8_WAIT_V(8); PG8_WAIT_L(0); PG8_BAR; PG8_MMA(0, 0, At, B0); PG8_MMA(0, 1, At, B1); PG8_BAR; PG8_SCHED;
            PG8_LDA(At, 0, 1); PG8_STAGE(PG8_SB(0, 0), b2, voffB); PG8_STAGE(PG8_SB(0, 1), b2 + hB, voffB); PG8_STAGE(PG8_SA(0, 0), a2, voffA);
            PG8_WAIT_V(8); PG8_WAIT_L(0); PG8_BAR; PG8_MMA(1, 0, At, B0); PG8_MMA(1, 1, At, B1); PG8_BAR; PG8_SCHED;
            PG8_LDB(B0, 1, 0); PG8_LDB(B1, 1, 1); PG8_SCHED; PG8_LDA(At, 1, 0); PG8_STAGE(PG8_SA(0, 1), a2 + hA, voffA);
            PG8_WAIT_V(8); PG8_WAIT_L(0); PG8_BAR; PG8_MMA(0, 0, At, B0); PG8_MMA(0, 1, At, B1); PG8_BAR; PG8_SCHED;
            PG8_LDA(At, 1, 1); PG8_STAGE(PG8_SB(1, 0), b3, voffB); PG8_STAGE(PG8_SB(1, 1), b3 + hB, voffB); PG8_STAGE(PG8_SA(1, 0), a3, voffA);
            PG8_WAIT_V(8); PG8_WAIT_L(0); PG8_BAR; PG8_MMA(1, 0, At, B0); PG8_MMA(1, 1, At, B1); PG8_BAR; PG8_SCHED;
        }
        if (wr == 0) PG8_BAR;
        E(acc, cur, wr, wc, fr, fq);
        if (!has_next) break;
#pragma unroll
        for (int a = 0; a < 2; ++a)
#pragma unroll
            for (int b = 0; b < 2; ++b)
#pragma unroll
                for (int m = 0; m < 4; ++m)
#pragma unroll
                    for (int n = 0; n < 2; ++n) acc[a][b][m][n] = (f32x4){0.f, 0.f, 0.f, 0.f};
        cur = nxt; cA = nA; cB = nB; ++ui;
        if (wr == 1) PG8_BAR;
    }
    PG8_WAIT_V(0);
    PG8_BAR;
#undef PG8_SA
#undef PG8_SB
#undef PG8_STAGE
#undef PG8_LDA
#undef PG8_LDB
#undef PG8_MMA
#undef PG8_WAIT_V
#undef PG8_WAIT_L
#undef PG8_BAR
#undef PG8_SCHED
}

#define EPI_LOOP_BEGIN \
    _Pragma("unroll") for (int ai = 0; ai < 2; ++ai) _Pragma("unroll") for (int m = 0; m < 4; ++m) { const int row = u.pm * BM + ai * HALF + wr * 64 + m * 16 + fr; \
    _Pragma("unroll") for (int bj = 0; bj < 2; ++bj) { const int col = u.pn * BM + bj * HALF + wc * 32 + 8 * fq; const f32x4 v0 = acc[ai][bj][m][0], v1 = acc[ai][bj][m][1];
#define EPI_LOOP_END } }
__device__ __forceinline__ u32x4 pack8(f32x4 a, f32x4 b) { u32x4 w; w.x = pk2(a[0], a[1]); w.y = pk2(a[2], a[3]); w.z = pk2(b[0], b[1]); w.w = pk2(b[2], b[3]); return w; }

struct EpiPlain { bf16* O; int ldc;
    __device__ __forceinline__ void operator()(const f32x4 (&acc)[2][2][4][2], const Unit& u, int wr, int wc, int fr, int fq) const {
        EPI_LOOP_BEGIN
            *(u32x4*)(O + (size_t)row * ldc + col) = pack8(v0, v1);
        EPI_LOOP_END
    } };
struct EpiHybIn { bf16* z; bf16* xraw; bf16* ug;
    __device__ __forceinline__ void operator()(const f32x4 (&acc)[2][2][4][2], const Unit& u, int wr, int wc, int fr, int fq) const {
        EPI_LOOP_BEGIN
            if (u.pn < 4) *(u32x4*)(z + (size_t)row * 1024 + col) = pack8(v0, v1);
            else if (u.pn < 10) *(u32x4*)(xraw + (size_t)row * 1536 + (col - 1024)) = pack8(v0, v1);
            else { const int j = col - 2560, gg = j >> 4, cp = j & 15, chunk = row >> 4, s = row & 15;
                   *(u32x4*)(ug + ((size_t)(gg * 2048 + chunk)) * 384 + s * 16 + cp) = pack8(v0, v1); }
        EPI_LOOP_END
    } };
struct EpiQKV { bf16* base;
    __device__ __forceinline__ void operator()(const f32x4 (&acc)[2][2][4][2], const Unit& u, int wr, int wc, int fr, int fq) const {
        EPI_LOOP_BEGIN
            const int sect = col >> 10, hh = (col >> 7) & 7, d = col & 127, b = row >> 13, t = row & 8191;
            *(u32x4*)(base + (((size_t)(sect * 4 + b) * 8 + hh) * 8192 + t) * 128 + d) = pack8(v0, v1);
        EPI_LOOP_END
    } };
struct EpiSwiglu { bf16* hid;
    __device__ __forceinline__ void operator()(const f32x4 (&acc)[2][2][4][2], const Unit& u, int wr, int wc, int fr, int fq) const {
#pragma unroll
        for (int ai = 0; ai < 2; ++ai)
#pragma unroll
            for (int m = 0; m < 4; ++m) { const int row = u.pm * BM + ai * HALF + wr * 64 + m * 16 + fr; const int col = u.pn * 128 + wc * 32 + 8 * fq;
                f32x4 r0, r1;
#pragma unroll
                for (int i = 0; i < 4; ++i) { r0[i] = siluf(acc[ai][0][m][0][i]) * acc[ai][1][m][0][i]; r1[i] = siluf(acc[ai][0][m][1][i]) * acc[ai][1][m][1][i]; }
                *(u32x4*)(hid + (size_t)row * 2816 + col) = pack8(r0, r1); }
    } };
struct EpiGlu { const bf16* y; const float* gb; bf16* ycat;
    __device__ __forceinline__ void operator()(const f32x4 (&acc)[2][2][4][2], const Unit& u, int wr, int wc, int fr, int fq) const {
        EPI_LOOP_BEGIN
            float yv[8]; unpack8(*(const u32x4*)(y + (size_t)row * 1024 + col), yv);
            const f32x4 b0 = *(const f32x4*)(gb + col), b1 = *(const f32x4*)(gb + col + 4); f32x4 r0, r1;
#pragma unroll
            for (int i = 0; i < 4; ++i) { r0[i] = yv[i] * sigmf(v0[i] + b0[i]); r1[i] = yv[4 + i] * sigmf(v1[i] + b1[i]); }
            *(u32x4*)(ycat + (size_t)row * 2048 + 1024 + col) = pack8(r0, r1);
            __builtin_amdgcn_sched_barrier(0);
        EPI_LOOP_END
    } };
struct EpiS5State { float* hloc;
    __device__ __forceinline__ void operator()(const f32x4 (&acc)[2][2][4][2], const Unit& u, int wr, int wc, int fr, int fq) const {
#pragma unroll
        for (int ai = 0; ai < 2; ++ai)
#pragma unroll
            for (int m = 0; m < 4; ++m) { const int row = u.pm * BM + ai * HALF + wr * 64 + m * 16 + fr; const int col = wc * 32 + 8 * fq;
                *(f32x4*)(hloc + (size_t)row * 128 + col) = acc[ai][0][m][0]; *(f32x4*)(hloc + (size_t)row * 128 + col + 4) = acc[ai][0][m][1]; }
    } };
struct EpiS5Y { const bf16* ug; const float* dsk; bf16* s5y;
    __device__ __forceinline__ void operator()(const f32x4 (&acc)[2][2][4][2], const Unit& u, int wr, int wc, int fr, int fq) const {
        EPI_LOOP_BEGIN
            const int gg = row >> 11, chunk = row & 2047, t = col >> 4, c0 = col & 15, tok = chunk * 16 + t, ch = gg * 16 + c0;
            f32x4 r0, r1;
#pragma unroll
            for (int i = 0; i < 4; ++i) { r0[i] = gelu_erf(v0[i]); r1[i] = gelu_erf(v1[i]); }
            *(u32x4*)(s5y + (size_t)tok * 1024 + ch) = pack8(r0, r1);
            __builtin_amdgcn_sched_barrier(0);
        EPI_LOOP_END
    } };
}

__device__ __forceinline__ void tr_item(const float* W, int N, int src_c0, bf16* WT, int K, int dst_r0, int k0, LAS float* scr, int lane) {
    f32x4 v[16];
    const int kr = lane >> 4, nc = (lane & 15) * 4;
#pragma unroll
    for (int i = 0; i < 16; ++i) v[i] = *(const f32x4*)(W + (size_t)(k0 + 4 * i + kr) * N + src_c0 + nc);
#pragma unroll
    for (int i = 0; i < 16; ++i) { LAS float* d = scr + (4 * i + kr) * 65 + nc; d[0] = v[i][0]; d[1] = v[i][1]; d[2] = v[i][2]; d[3] = v[i][3]; }
    LDS_WAIT(); __builtin_amdgcn_wave_barrier();
    const int c = lane & 7;
#pragma unroll
    for (int j = 0; j < 8; ++j) { const int n = (lane >> 3) + 8 * j; const LAS float* q = scr + (8 * c) * 65 + n;
        u32x4 o; o.x = pk2(q[0 * 65], q[1 * 65]); o.y = pk2(q[2 * 65], q[3 * 65]); o.z = pk2(q[4 * 65], q[5 * 65]); o.w = pk2(q[6 * 65], q[7 * 65]);
        *(u32x4*)(WT + (size_t)(dst_r0 + n) * K + k0 + 8 * c) = o; }
    LDS_WAIT(); __builtin_amdgcn_wave_barrier();
}

template <int MAP>
__device__ __forceinline__ void tr_matrix_item(const float* W, int N, bf16* WT, int K, int NR, int item, LAS float* scr, int lane) {
    const int nrb = NR / 64, kb = item / nrb, rb = item % nrb, r0 = rb * 64;
    int sc;
    if (MAP == 0) sc = r0;
    else if (MAP == 1) sc = r0 < 2560 ? r0 : r0 + 16;
    else { const int t = r0 >> 8, w = r0 & 255; sc = w < 128 ? 128 * t + w : 2816 + 128 * t + (w - 128); }
    tr_item(W, N, sc, WT, K, r0, kb * 64, scr, lane);
}

__device__ __forceinline__ void phase_prologue(const Params& P, LAS unsigned char* lds) {
    const int tid = threadIdx.x, lane = tid & 63, wave = __builtin_amdgcn_readfirstlane(tid >> 6);
    unsigned char* ws = P.ws;
    if (blockIdx.x < 64) {
        const int g = blockIdx.x;
        LAS float* pwr = (LAS float*)lds;
        LAS float* pwi = pwr + 17 * 64;
        LAS float* qq = pwi + 17 * 64;
        LAS float* bbr = qq + 128;
        LAS float* bbi = bbr + 1024;
        LAS float* ccr = bbi + 1024;
        LAS float* cci = ccr + 1024;
        LAS float* Kd = cci + 1024;
        const float* lam_re = P.in[17]; const float* lam_im = P.in[18]; const float* log_dt = P.in[19];
        const float* b_re = P.in[20]; const float* b_im = P.in[21]; const float* c_re = P.in[22]; const float* c_im = P.in[23];
        for (int e = tid; e < 17 * 64; e += 512) { const int p = e & 63, d = e >> 6; const float lre = lam_re[g * 64 + p], lim = lam_im[g * 64 + p], dt = expf(log_dt[g]);
            const float mag = expf(lre * dt * (float)d), ang = lim * dt * (float)d; pwr[d * 64 + p] = mag * cosf(ang); pwi[d * 64 + p] = mag * sinf(ang); }
        __syncthreads();
        if (tid < 64) {
            const int p = tid; const float lre = lam_re[g * 64 + p], lim = lam_im[g * 64 + p];
            const float are = pwr[64 + p], aim = pwi[64 + p], den = lre * lre + lim * lim;
            qq[2 * p] = ((are - 1.f) * lre + aim * lim) / den; qq[2 * p + 1] = (aim * lre - (are - 1.f) * lim) / den;
            float* a16 = (float*)(ws + WS_A16); a16[(g * 64 + p) * 2] = pwr[16 * 64 + p]; a16[(g * 64 + p) * 2 + 1] = pwi[16 * 64 + p];
        }
        __syncthreads();
        for (int e = tid; e < 1024; e += 512) { const int p = e >> 4, cp = e & 15; const float br = b_re[(g * 64 + p) * 16 + cp], bi = b_im[(g * 64 + p) * 16 + cp], qr = qq[2 * p], qi = qq[2 * p + 1];
            bbr[e] = qr * br - qi * bi; bbi[e] = qr * bi + qi * br;
            const int c = e >> 6, p2 = e & 63; ccr[e] = c_re[(g * 16 + c) * 64 + p2]; cci[e] = c_im[(g * 16 + c) * 64 + p2]; }
        __syncthreads();
        for (int e = tid; e < 4096; e += 512) { const int d = e >> 8, c = (e >> 4) & 15, cp = e & 15; float s = 0.f;
            for (int p = 0; p < 64; ++p) { const float pr = pwr[d * 64 + p], pi = pwi[d * 64 + p], br = bbr[p * 16 + cp], bi = bbi[p * 16 + cp];
                const float tr = pr * br - pi * bi, ti = pr * bi + pi * br; s += ccr[c * 64 + p] * tr - cci[c * 64 + p] * ti; }
            Kd[e] = s; }
        __syncthreads();
        bf16* toec = (bf16*)(ws + WS_TOEC) + (size_t)g * 256 * 384;
        for (int e = tid; e < 256 * 384; e += 512) { const int n = e / 384, k = e % 384, t = n >> 4, c = n & 15; float val;
            if (k < 256) { const int s = k >> 4, cp = k & 15; val = t >= s ? Kd[((t - s) * 16 + c) * 16 + cp] : 0.f; if (t == s && c == cp) val += P.in[24][g * 16 + c]; }
            else { const int j = k - 256, p = j & 63; const float pr = pwr[(t + 1) * 64 + p], pi = pwi[(t + 1) * 64 + p], cr = ccr[c * 64 + p], ci = cci[c * 64 + p];
                   val = j < 64 ? (cr * pr - ci * pi) : -(cr * pi + ci * pr); }
            toec[e] = (bf16)f2bf(val); }
        bf16* bpow = (bf16*)(ws + WS_BPOW) + (size_t)g * 256 * 256;
        for (int e = tid; e < 256 * 256; e += 512) { const int n = e >> 8, k = e & 255; float val = 0.f;
            if (n < 128) { const int p = n & 63, s = k >> 4, cp = k & 15; const float pr = pwr[(15 - s) * 64 + p], pi = pwi[(15 - s) * 64 + p], br = bbr[p * 16 + cp], bi = bbi[p * 16 + cp];
                val = n < 64 ? (pr * br - pi * bi) : (pr * bi + pi * br); }
            bpow[e] = (bf16)f2bf(val); }
        __syncthreads();
    }
    const int tr0 = gridDim.x > 160 ? 112 : 0;
    const int gw = ((int)blockIdx.x - tr0) * 8 + wave, NGW = ((int)gridDim.x - tr0) * 8;
    {
        const float* cvec = P.in[1]; const float* ada_w = P.in[2]; const float* ada_b = P.in[3]; float* mod = (float*)(ws + WS_MOD);
        LAS float* part = (LAS float*)lds;
        for (int it = (int)blockIdx.x - 64; it >= 0 && it < 48; it += gridDim.x) {
            const int li = it / 24, cb = it % 24, col = cb * 256 + 4 * lane;
            f32x4 a0 = {0.f, 0.f, 0.f, 0.f}, a1 = a0, a2 = a0, a3 = a0;
            const float* wp = ada_w + ((size_t)li * 1024 + wave * 128) * 6144 + col;
#pragma unroll 16
            for (int k = 0; k < 128; ++k) { const f32x4 w = *(const f32x4*)(wp + (size_t)k * 6144); const int kk = wave * 128 + k;
                a0 += w * siluf(cvec[kk]); a1 += w * siluf(cvec[1024 + kk]); a2 += w * siluf(cvec[2048 + kk]); a3 += w * siluf(cvec[3072 + kk]); }
            *(LAS f32x4*)(part + (wave * 4 + 0) * 256 + 4 * lane) = a0; *(LAS f32x4*)(part + (wave * 4 + 1) * 256 + 4 * lane) = a1;
            *(LAS f32x4*)(part + (wave * 4 + 2) * 256 + 4 * lane) = a2; *(LAS f32x4*)(part + (wave * 4 + 3) * 256 + 4 * lane) = a3;
            __syncthreads();
            { const int c = tid & 255, b0 = (tid >> 8) * 2;
#pragma unroll
              for (int bb = 0; bb < 2; ++bb) { float sacc = ada_b[li * 6144 + cb * 256 + c];
#pragma unroll
                  for (int w = 0; w < 8; ++w) sacc += part[(w * 4 + b0 + bb) * 256 + c];
                  mod[((size_t)li * 4 + b0 + bb) * 6144 + cb * 256 + c] = sacc; } }
            __syncthreads();
        }
    }
    {
        LAS float* scr = (LAS float*)lds + wave * (64 * 65);
        constexpr int I0 = 16 * 56, I1 = 16 * 16, I2 = 32 * 16, I3 = 16 * 88, I4 = 44 * 16, I5 = 16 * 80, I6 = 16 * 16;
        constexpr int NIT = I0 + I1 + I2 + 2 * I3 + 2 * I4 + I5 + I6;
        if (gw >= 0) for (int it = gw; it < NIT; it += NGW) {
            int r = it;
            if (r < I0) { tr_matrix_item<1>(P.in[10], 3600, (bf16*)(ws + WS_WHYBIN), 1024, 3584, r, scr, lane); continue; } r -= I0;
            if (r < I1) { tr_matrix_item<0>(P.in[25], 1024, (bf16*)(ws + WS_WGLU), 1024, 1024, r, scr, lane); continue; } r -= I1;
            if (r < I2) { tr_matrix_item<0>(P.in[27], 1024, (bf16*)(ws + WS_WHYBOUT), 2048, 1024, r, scr, lane); continue; } r -= I2;
            if (r < I3) { tr_matrix_item<2>(P.in[8], 5632, (bf16*)(ws + WS_WFFIN), 1024, 5632, r, scr, lane); continue; } r -= I3;
            if (r < I3) { tr_matrix_item<2>(P.in[8] + (size_t)1024 * 5632, 5632, (bf16*)(ws + WS_WFFIN) + (size_t)5632 * 1024, 1024, 5632, r, scr, lane); continue; } r -= I3;
            if (r < I4) { tr_matrix_item<0>(P.in[9], 1024, (bf16*)(ws + WS_WFFOUT), 2816, 1024, r, scr, lane); continue; } r -= I4;
            if (r < I4) { tr_matrix_item<0>(P.in[9] + (size_t)2816 * 1024, 1024, (bf16*)(ws + WS_WFFOUT) + (size_t)1024 * 2816, 2816, 1024, r, scr, lane); continue; } r -= I4;
            if (r < I5) { tr_matrix_item<0>(P.in[28], 5120, (bf16*)(ws + WS_WQKV), 1024, 5120, r, scr, lane); continue; } r -= I5;
            tr_matrix_item<0>(P.in[29], 1024, (bf16*)(ws + WS_WO), 1024, 1024, r, scr, lane);
        }
    }
}

template <int MODE, int XIN16, int XOUT16>
__device__ __forceinline__ void phase_norm(const Params& P, LAS unsigned char* lds, const void* xin_, void* xout_, const float* gpost, const float* modgt,
                                           const float* gpre, const float* modsc, const float* modsh) {
    const float* xin = (const float*)xin_; const bf16* xin16 = (const bf16*)xin_; float* xout = (float*)xout_; bf16* xout16 = (bf16*)xout_;
    const int tid = threadIdx.x, lane = tid & 63, wave = __builtin_amdgcn_readfirstlane(tid >> 6);
    unsigned char* ws = P.ws;
    LAS float* wdt = (LAS float*)lds;
    if (MODE == 0) {
        const float* W = P.in[10];
        for (int e = tid; e < 16 * 1024; e += 512) { const int k = e >> 4, o = e & 15; wdt[o * 1024 + k] = W[(size_t)k * 3600 + 2560 + o]; }
        __syncthreads();
    }
    const bf16* Y = (const bf16*)(ws + WS_Y); bf16* H = (bf16*)(ws + WS_H); float* dtraw = (float*)(ws + WS_DTRAW);
    const int gw = blockIdx.x * 8 + wave, NGW = gridDim.x * 8;
    f32x4 Gpost[4], Gpre[4];
#pragma unroll
    for (int j = 0; j < 4; ++j) { const int c = 4 * lane + 256 * j; if (MODE != 0) Gpost[j] = *(const f32x4*)(gpost + c); if (MODE != 2) Gpre[j] = *(const f32x4*)(gpre + c); }
    u32x2 c16[2][4], n16[2][4], yr[2][4], ny[2][4]; f32x4 c32[2][4], n32[2][4];
#define NORM_LOAD(R16, R32, YR, r0_) do { _Pragma("unroll") for (int rr_ = 0; rr_ < 2; ++rr_) { const size_t ro_ = (size_t)((r0_) + rr_ * NGW) * DM + 4 * lane; \
        _Pragma("unroll") for (int j_ = 0; j_ < 4; ++j_) { if (XIN16) R16[rr_][j_] = *(const u32x2*)(xin16 + ro_ + 256 * j_); else R32[rr_][j_] = *(const f32x4*)(xin + ro_ + 256 * j_); \
            if (MODE != 0) YR[rr_][j_] = *(const u32x2*)(Y + ro_ + 256 * j_); } } } while (0)
    NORM_LOAD(c16, c32, yr, gw);
    f32x4 Gt[4], Sc[4], Sh[4];
#pragma unroll 1
    for (int row0 = gw; row0 < NTOK; row0 += 2 * NGW) {
        if (row0 + 2 * NGW < NTOK) NORM_LOAD(n16, n32, ny, row0 + 2 * NGW);
        if (((row0 - gw) / (2 * NGW) & 1) == 0) {
            const int bq = row0 >> 13;
#pragma unroll
            for (int j = 0; j < 4; ++j) { const int c = 4 * lane + 256 * j; if (MODE != 0) Gt[j] = *(const f32x4*)(modgt + bq * 6144 + c);
                if (MODE != 2) { Sc[j] = *(const f32x4*)(modsc + bq * 6144 + c); Sh[j] = *(const f32x4*)(modsh + bq * 6144 + c); } } }
        f32x4 v[2][4];
#pragma unroll
        for (int rr = 0; rr < 2; ++rr)
#pragma unroll
            for (int j = 0; j < 4; ++j) { if (XIN16) v[rr][j] = (f32x4){bflo(c16[rr][j].x), bfhi(c16[rr][j].x), bflo(c16[rr][j].y), bfhi(c16[rr][j].y)}; else v[rr][j] = c32[rr][j]; }
#pragma unroll
        for (int rr = 0; rr < 2; ++rr) { const int row = row0 + rr * NGW;
        if (MODE != 0) {
            float s = 0.f;
#pragma unroll
            for (int j = 0; j < 4; ++j) { const f32x4 yy = {bflo(yr[rr][j].x), bfhi(yr[rr][j].x), bflo(yr[rr][j].y), bfhi(yr[rr][j].y)}; s += (yy[0] * yy[0] + yy[1] * yy[1]) + (yy[2] * yy[2] + yy[3] * yy[3]); }
            const float r1 = rsqrtf(wave_sum(s) * (1.f / DM) + EPS);
#pragma unroll
            for (int j = 0; j < 4; ++j) { const int c = 4 * lane + 256 * j; const f32x4 g = Gpost[j], gt = Gt[j];
                const f32x4 yy = {bflo(yr[rr][j].x), bfhi(yr[rr][j].x), bflo(yr[rr][j].y), bfhi(yr[rr][j].y)};
                v[rr][j] = v[rr][j] + gt * (yy * r1 * g);
                if (XOUT16) { u32x2 o; o.x = pk2(v[rr][j][0], v[rr][j][1]); o.y = pk2(v[rr][j][2], v[rr][j][3]); *(u32x2*)(xout16 + (size_t)row * DM + c) = o; }
                else *(f32x4*)(xout + (size_t)row * DM + c) = v[rr][j]; }
        }
        if (MODE != 2) {
            float s = 0.f;
#pragma unroll
            for (int j = 0; j < 4; ++j) s += (v[rr][j][0] * v[rr][j][0] + v[rr][j][1] * v[rr][j][1]) + (v[rr][j][2] * v[rr][j][2] + v[rr][j][3] * v[rr][j][3]);
            const float r2 = rsqrtf(wave_sum(s) * (1.f / DM) + EPS);
#pragma unroll
            for (int j = 0; j < 4; ++j) { const int c = 4 * lane + 256 * j; const f32x4 g = Gpre[j], sc = Sc[j], sh = Sh[j];
                v[rr][j] = (v[rr][j] * r2 * g) * (sc + 1.f) + sh;
                u32x2 o; o.x = pk2(v[rr][j][0], v[rr][j][1]); o.y = pk2(v[rr][j][2], v[rr][j][3]); *(u32x2*)(H + (size_t)row * DM + c) = o; }
            if (MODE == 0) {
                float a[16];
#pragma unroll
                for (int o = 0; o < 16; ++o) { float t = 0.f;
#pragma unroll
                    for (int j = 0; j < 4; ++j) { const f32x4 w = *(const LAS f32x4*)(wdt + o * 1024 + 4 * lane + 256 * j); t += (v[rr][j][0] * w[0] + v[rr][j][1] * w[1]) + (v[rr][j][2] * w[2] + v[rr][j][3] * w[3]); }
                    a[o] = t; if ((o & 1) == 1) __builtin_amdgcn_sched_barrier(0); }
#pragma unroll
                for (int i = 0; i < 8; ++i) { const bool up = lane & 32; const float keep = up ? a[i + 8] : a[i], send = up ? a[i] : a[i + 8]; a[i] = keep + __shfl_xor(send, 32); }
#pragma unroll
                for (int i = 0; i < 4; ++i) { const bool up = lane & 16; const float keep = up ? a[i + 4] : a[i], send = up ? a[i] : a[i + 4]; a[i] = keep + __shfl_xor(send, 16); }
#pragma unroll
                for (int i = 0; i < 2; ++i) { const bool up = lane & 8; const float keep = up ? a[i + 2] : a[i], send = up ? a[i] : a[i + 2]; a[i] = keep + __shfl_xor(send, 8); }
                { const bool up = lane & 4; const float keep = up ? a[1] : a[0], send = up ? a[0] : a[1]; a[0] = keep + __shfl_xor(send, 4); }
                a[0] += __shfl_xor(a[0], 2); a[0] += __shfl_xor(a[0], 1);
                if ((lane & 3) == 0) dtraw[(size_t)row * 16 + ((lane >> 5) & 1) * 8 + ((lane >> 4) & 1) * 4 + ((lane >> 3) & 1) * 2 + ((lane >> 2) & 1)] = a[0];
            }
        }
        }
#pragma unroll
        for (int rr = 0; rr < 2; ++rr)
#pragma unroll
            for (int j = 0; j < 4; ++j) { c16[rr][j] = n16[rr][j]; c32[rr][j] = n32[rr][j]; yr[rr][j] = ny[rr][j]; }
    }
#undef NORM_LOAD
    if (MODE == 0) __syncthreads();
}

__device__ __forceinline__ void phase_conv(const Params& P) {
    const int tid = threadIdx.x, lane = tid & 63, wave = __builtin_amdgcn_readfirstlane(tid >> 6);
    const bf16* xraw = (const bf16*)P.out; bf16* xbc = (bf16*)(P.ws + WS_XBC);
    const float* cw = P.in[11]; const float* cb = P.in[12];
    const int gw = blockIdx.x * 8 + wave, NGW = gridDim.x * 8;
    u32x4 rawn[11];
#define CONV_LOAD(R, iw_) do { const int rb_ = (iw_) / 3, cgb_ = (iw_) - rb_ * 3, ch_ = (cgb_ * 64 + lane) * 8, tk_ = rb_ * 8, ti_ = tk_ & 8191; \
        _Pragma("unroll") for (int r_ = 0; r_ < 11; ++r_) { if (ti_ + r_ - 3 >= 0) R[r_] = *(const u32x4*)(xraw + (size_t)(tk_ + r_ - 3) * 1536 + ch_); else R[r_] = (u32x4){0u, 0u, 0u, 0u}; } } while (0)
    if (gw < 4096 * 3) CONV_LOAD(rawn, gw);
#pragma unroll 1
    for (int iw = gw; iw < 4096 * 3; iw += NGW) {
        const int rb = iw / 3, cgb = iw - rb * 3, ch0 = (cgb * 64 + lane) * 8, tok0 = rb * 8;
        u32x4 raw[11];
#pragma unroll
        for (int r = 0; r < 11; ++r) raw[r] = rawn[r];
        if (iw + NGW < 4096 * 3) CONV_LOAD(rawn, iw + NGW);
        float w[4][8], bias[8];
#pragma unroll
        for (int k = 0; k < 4; ++k) { const f32x4 w0 = *(const f32x4*)(cw + k * 1536 + ch0), w1 = *(const f32x4*)(cw + k * 1536 + ch0 + 4);
            w[k][0] = w0[0]; w[k][1] = w0[1]; w[k][2] = w0[2]; w[k][3] = w0[3]; w[k][4] = w1[0]; w[k][5] = w1[1]; w[k][6] = w1[2]; w[k][7] = w1[3]; }
        { const f32x4 b0 = *(const f32x4*)(cb + ch0), b1 = *(const f32x4*)(cb + ch0 + 4); bias[0] = b0[0]; bias[1] = b0[1]; bias[2] = b0[2]; bias[3] = b0[3]; bias[4] = b1[0]; bias[5] = b1[1]; bias[6] = b1[2]; bias[7] = b1[3]; }
#pragma unroll
        for (int t = 0; t < 8; ++t) { float a[8];
#pragma unroll
            for (int e = 0; e < 8; ++e) a[e] = bias[e];
#pragma unroll
            for (int k = 0; k < 4; ++k) { float x[8]; unpack8(raw[t + k], x);
#pragma unroll
                for (int e = 0; e < 8; ++e) a[e] += w[k][e] * x[e]; }
            u32x4 o; o.x = pk2(siluf(a[0]), siluf(a[1])); o.y = pk2(siluf(a[2]), siluf(a[3])); o.z = pk2(siluf(a[4]), siluf(a[5])); o.w = pk2(siluf(a[6]), siluf(a[7]));
            *(u32x4*)(xbc + (size_t)(tok0 + t) * 1536 + ch0) = o; }
    }
}
__device__ __forceinline__ unsigned pair_lo(unsigned a, unsigned c) { return (a & 0xffffu) | (c << 16); }
__device__ __forceinline__ unsigned pair_hi(unsigned a, unsigned c) { return (a >> 16) | (c & 0xffff0000u); }
__device__ __forceinline__ void ssd_dt_acum(const Params& P, LAS float* DT, LAS float* AC, int tok0, int h, int hh, int lane) {
    const float* dtraw = (const float*)(P.ws + WS_DTRAW);
    const float bias = P.in[13][h], A = -expf(P.in[14][h]);
    float carry = 0.f;
#pragma unroll
    for (int half = 0; half < 2; ++half) {
        const int s = lane + 64 * half; const float raw = dtraw[(size_t)(tok0 + s) * 16 + h] + bias;
        const float dt = raw > 20.f ? raw : log1pf(expf(raw));
        float v = dt * A;
#pragma unroll
        for (int o = 1; o < 64; o <<= 1) { const float t = __shfl_up(v, o); if (lane >= o) v += t; }
        v += carry; carry = __shfl(v, 63);
        DT[hh * 128 + s] = dt; AC[hh * 128 + s] = v;
    }
}

__device__ __forceinline__ void ssd_local_unit(const Params& P, LAS unsigned char* lds, int unit) {
    const int tid = threadIdx.x, lane = tid & 63, wave = __builtin_amdgcn_readfirstlane(tid >> 6), fr = lane & 15, fq = lane >> 4;
    const int gq = unit & 1, c = (unit >> 1) & 63, b = unit >> 7, tok0 = b * SEQ + c * 128, h = gq * 8 + wave;
    const bf16* xbc = (const bf16*)(P.ws + WS_XBC);
    LAS bf16* BT = (LAS bf16*)lds;
    LAS unsigned* BT32 = (LAS unsigned*)lds;
    LAS float* DT = (LAS float*)(lds + 34816);
    LAS float* AC = (LAS float*)(lds + 38912);
    LAS bf16* XsT = (LAS bf16*)(lds + 43008 + wave * 9216);
    LAS unsigned* XsT32 = (LAS unsigned*)(lds + 43008 + wave * 9216);
    u32x4 br[2][2], xr0[4][2], xr1[4][2];
#pragma unroll
    for (int r = 0; r < 2; ++r) { const bf16* bp = xbc + (size_t)(tok0 + 2 * lane) * 1536 + 1024 + gq * 128 + (wave + 8 * r) * 8; br[r][0] = *(const u32x4*)bp; br[r][1] = *(const u32x4*)(bp + 1536); }
#define SL_XLOAD(XR, half_) do { _Pragma("unroll") for (int it_ = 0; it_ < 4; ++it_) { const int pg_ = (lane >> 5) + 2 * it_; \
        const bf16* xp_ = xbc + (size_t)(tok0 + 64 * (half_) + 2 * (lane & 31)) * 1536 + h * 64 + pg_ * 8; XR[it_][0] = *(const u32x4*)xp_; XR[it_][1] = *(const u32x4*)(xp_ + 1536); } } while (0)
    SL_XLOAD(xr0, 0);
    SL_XLOAD(xr1, 1);
    ssd_dt_acum(P, DT, AC, tok0, h, wave, lane);
#pragma unroll
    for (int r = 0; r < 2; ++r) { const int ng = wave + 8 * r;
        const u32x4 a = br[r][0], cc = br[r][1];
        LAS unsigned* d = BT32 + (ng * 8) * 68 + lane;
        d[0] = pair_lo(a.x, cc.x); d[68] = pair_hi(a.x, cc.x); d[2 * 68] = pair_lo(a.y, cc.y); d[3 * 68] = pair_hi(a.y, cc.y);
        d[4 * 68] = pair_lo(a.z, cc.z); d[5 * 68] = pair_hi(a.z, cc.z); d[6 * 68] = pair_lo(a.w, cc.w); d[7 * 68] = pair_hi(a.w, cc.w); }
    __syncthreads();
    f32x4 acc[4][8];
#pragma unroll
    for (int mt = 0; mt < 4; ++mt)
#pragma unroll
        for (int nt = 0; nt < 8; ++nt) acc[mt][nt] = (f32x4){0.f, 0.f, 0.f, 0.f};
    const float aend = AC[wave * 128 + 127];
#define SL_HALF(XR, half_) do { \
        { const int i_ = lane & 31, s0_ = 64 * (half_) + 2 * i_; \
          const float sc0_ = DT[wave * 128 + s0_] * __expf(aend - AC[wave * 128 + s0_]), sc1_ = DT[wave * 128 + s0_ + 1] * __expf(aend - AC[wave * 128 + s0_ + 1]); \
          _Pragma("unroll") for (int it_ = 0; it_ < 4; ++it_) { const int pg_ = (lane >> 5) + 2 * it_; float x0_[8], x1_[8]; unpack8(XR[it_][0], x0_); unpack8(XR[it_][1], x1_); \
              LAS unsigned* d_ = XsT32 + (pg_ * 8) * 36 + i_; \
              _Pragma("unroll") for (int e_ = 0; e_ < 8; ++e_) d_[e_ * 36] = pk2(x0_[e_] * sc0_, x1_[e_] * sc1_); } } \
        WAVE_SYNC(); \
        _Pragma("unroll") for (int ks = 0; ks < 2; ++ks) { \
            bf16x8 af[4]; \
            _Pragma("unroll") for (int mt = 0; mt < 4; ++mt) af[mt] = *(const LAS bf16x8*)(XsT + (16 * mt + fr) * 72 + 32 * ks + 8 * fq); \
            _Pragma("unroll") for (int nt = 0; nt < 8; ++nt) { const bf16x8 bfr = *(const LAS bf16x8*)(BT + (16 * nt + fr) * 136 + 64 * (half_) + 32 * ks + 8 * fq); \
                _Pragma("unroll") for (int mt = 0; mt < 4; ++mt) acc[mt][nt] = MFMA16(bfr, af[mt], acc[mt][nt]); } } \
        WAVE_SYNC(); } while (0)
    SL_HALF(xr0, 0);
    SL_HALF(xr1, 1);
#undef SL_XLOAD
#undef SL_HALF
    bf16* S = (bf16*)(P.ws + WS_SSDST) + ((size_t)((b * 64 + c) * 16 + h)) * 8192;
#pragma unroll
    for (int mt = 0; mt < 4; ++mt)
#pragma unroll
        for (int nt = 0; nt < 8; ++nt) { u32x2 o; o.x = pk2(acc[mt][nt][0], acc[mt][nt][1]); o.y = pk2(acc[mt][nt][2], acc[mt][nt][3]);
            *(u32x2*)(S + (16 * mt + fr) * 128 + 16 * nt + 4 * fq) = o; }
    if (lane == 0) ((float*)(P.ws + WS_CD))[(b * 64 + c) * 16 + h] = __expf(aend);
    __syncthreads();
}

__device__ __forceinline__ void phase_scans(const Params& P) {
    const int tid = threadIdx.x;
    if (blockIdx.x < 32) {
        const int idx = blockIdx.x * 512 + tid, p = idx & 63, g = (idx >> 6) & 63, b = idx >> 12;
        const float* a16 = (const float*)(P.ws + WS_A16); const float ar = a16[(g * 64 + p) * 2], ai = a16[(g * 64 + p) * 2 + 1];
        const float* hl = (const float*)(P.ws + WS_HLOC) + ((size_t)(g * 2048 + b * 512)) * 128 + p;
        bf16* ug = (bf16*)(P.ws + WS_UG) + ((size_t)(g * 2048 + b * 512)) * 384 + 256 + p;
        float hr = 0.f, hi = 0.f;
        float lr0[16], li0[16], lr1[16], li1[16];
#define S5_LD(LR, LI, c0_) do { _Pragma("unroll") for (int i_ = 0; i_ < 16; ++i_) { LR[i_] = hl[(size_t)((c0_) + i_) * 128]; LI[i_] = hl[(size_t)((c0_) + i_) * 128 + 64]; } } while (0)
#define S5_RUN(LR, LI, c0_) do { _Pragma("unroll") for (int i_ = 0; i_ < 16; ++i_) { ug[(size_t)((c0_) + i_) * 384] = (bf16)f2bf(hr); ug[(size_t)((c0_) + i_) * 384 + 64] = (bf16)f2bf(hi); \
            const float nr_ = ar * hr - ai * hi + LR[i_], ni_ = ar * hi + ai * hr + LI[i_]; hr = nr_; hi = ni_; } } while (0)
        S5_LD(lr0, li0, 0);
#pragma unroll 1
        for (int c0 = 0; c0 < 512; c0 += 32) {
            S5_LD(lr1, li1, c0 + 16);
            S5_RUN(lr0, li0, c0);
            if (c0 + 32 < 512) S5_LD(lr0, li0, c0 + 32);
            S5_RUN(lr1, li1, c0 + 16);
        }
#undef S5_LD
#undef S5_RUN
    } else {
        const float* cd = (const float*)(P.ws + WS_CD);
        for (int it = (blockIdx.x - 32) * 512 + tid; it < 65536; it += (gridDim.x - 32) * 512) {
            const int off = (it & 1023) * 8, h = (it >> 10) & 15, b = it >> 14;
            bf16* S = (bf16*)(P.ws + WS_SSDST) + ((size_t)(b * 64) * 16 + h) * 8192 + off;
            const float* cdp = cd + (b * 64) * 16 + h;
            float run[8];
#pragma unroll
            for (int i = 0; i < 8; ++i) run[i] = 0.f;
            u32x4 ra[8], rb[8]; float da[8], db[8];
#define SSD_LD(R, D, c0_) do { _Pragma("unroll") for (int i_ = 0; i_ < 8; ++i_) { R[i_] = *(const u32x4*)(S + (size_t)((c0_) + i_) * 16 * 8192); D[i_] = cdp[((c0_) + i_) * 16]; } } while (0)
#define SSD_RUN(R, D, c0_) do { _Pragma("unroll") for (int i_ = 0; i_ < 8; ++i_) { float v_[8]; unpack8(R[i_], v_); \
            u32x4 o_; o_.x = pk2(run[0], run[1]); o_.y = pk2(run[2], run[3]); o_.z = pk2(run[4], run[5]); o_.w = pk2(run[6], run[7]); \
            *(u32x4*)(S + (size_t)((c0_) + i_) * 16 * 8192) = o_; \
            _Pragma("unroll") for (int e_ = 0; e_ < 8; ++e_) run[e_] = D[i_] * run[e_] + v_[e_]; } } while (0)
            SSD_LD(ra, da, 0);
#pragma unroll 1
            for (int c0 = 0; c0 < 64; c0 += 16) {
                SSD_LD(rb, db, c0 + 8);
                SSD_RUN(ra, da, c0);
                if (c0 + 16 < 64) SSD_LD(ra, da, c0 + 16);
                SSD_RUN(rb, db, c0 + 8);
            }
#undef SSD_LD
#undef SSD_RUN
        }
    }
}

__device__ __forceinline__ void ssd_out_unit(const Params& P, LAS unsigned char* lds, int unit) {
    const int tid = threadIdx.x, lane = tid & 63, wave = __builtin_amdgcn_readfirstlane(tid >> 6), fr = lane & 15, fq = lane >> 4;
    const int gq = unit & 1, c = (unit >> 1) & 63, b = unit >> 7, tok0 = b * SEQ + c * 128;
    const bf16* xbc = (const bf16*)(P.ws + WS_XBC); const bf16* Z = (const bf16*)(P.ws + WS_Z);
    bf16* ycat = (bf16*)P.out;
    LAS bf16* Cs = (LAS bf16*)lds;
    LAS bf16* CBs = (LAS bf16*)(lds + 34816);
    LAS bf16* Bs = (LAS bf16*)(lds + 69632);
    LAS bf16* XdT = (LAS bf16*)(lds + 69632);
    LAS unsigned* XdT32 = (LAS unsigned*)(lds + 69632);
    LAS float* DT = (LAS float*)(lds + 139264);
    LAS float* AC = (LAS float*)(lds + 143360);
    LAS float* SS = (LAS float*)(lds + 147456);
    ssd_dt_acum(P, DT, AC, tok0, gq * 8 + wave, wave, lane);
#pragma unroll
    for (int r = 0; r < 8; ++r) { const int it = tid + 512 * r, row = (it >> 4) & 127, g16 = it & 15, isC = it >> 11;
        const u32x4 v = *(const u32x4*)(xbc + (size_t)(tok0 + row) * 1536 + 1024 + isC * 256 + gq * 128 + g16 * 8);
        *(LAS u32x4*)((isC ? Cs : Bs) + row * 136 + g16 * 8) = v; }
    __syncthreads();
    {
        bf16x8 cf[4];
#pragma unroll
        for (int ks = 0; ks < 4; ++ks) cf[ks] = *(const LAS bf16x8*)(Cs + (16 * wave + fr) * 136 + 32 * ks + 8 * fq);
#pragma unroll
        for (int st = 0; st < 8; ++st) { f32x4 a = {0.f, 0.f, 0.f, 0.f};
#pragma unroll
            for (int ks = 0; ks < 4; ++ks) { const bf16x8 bfr = *(const LAS bf16x8*)(Bs + (16 * st + fr) * 136 + 32 * ks + 8 * fq); a = MFMA16(bfr, cf[ks], a); }
            u32x2 o; o.x = pk2(a[0], a[1]); o.y = pk2(a[2], a[3]); *(LAS u32x2*)(CBs + (16 * wave + fr) * 136 + 16 * st + 4 * fq) = o; }
    }
    __syncthreads();
#pragma unroll 1
    for (int pass = 0; pass < 2; ++pass) {
        {
            const int hl = wave >> 1, hh = 4 * pass + hl, h = gq * 8 + hh; const float d0 = DT[hh * 128 + 2 * lane], d1 = DT[hh * 128 + 2 * lane + 1];
#pragma unroll
            for (int it = 0; it < 4; ++it) { const int pg = 4 * (wave & 1) + it;
                const bf16* xp = xbc + (size_t)(tok0 + 2 * lane) * 1536 + h * 64 + pg * 8; float x0[8], x1[8]; unpack8(*(const u32x4*)xp, x0); unpack8(*(const u32x4*)(xp + 1536), x1);
                LAS unsigned* d = XdT32 + hl * (64 * 68) + (pg * 8) * 68 + lane;
#pragma unroll
                for (int e = 0; e < 8; ++e) d[e * 68] = pk2(x0[e] * d0, x1[e] * d1); }
        }
        bf16x8 pf[4][4];
        { const int h_ = gq * 8 + 4 * pass + (wave >> 1); const bf16* S_ = (const bf16*)(P.ws + WS_SSDST) + ((size_t)((b * 64 + c) * 16 + h_)) * 8192;
#pragma unroll
          for (int pt = 0; pt < 4; ++pt)
#pragma unroll
              for (int ks = 0; ks < 4; ++ks) pf[pt][ks] = __builtin_bit_cast(bf16x8, *(const u32x4*)(S_ + (16 * pt + fr) * 128 + 32 * ks + 8 * fq)); }
        __syncthreads();
        {
            const int hl = wave >> 1, hh = 4 * pass + hl, h = gq * 8 + hh, rh = wave & 1;
            LAS bf16* Xh = XdT + hl * (64 * 136);
            u32x2 zn[4];
#pragma unroll
            for (int pt = 0; pt < 4; ++pt) zn[pt] = *(const u32x2*)(Z + (size_t)(tok0 + 16 * rh + fr) * 1024 + h * 64 + 16 * pt + 4 * fq);
            const float dsk = P.in[15][h];
#pragma unroll 1
            for (int lt = 0; lt < 4; ++lt) {
                const int l0 = 16 * (2 * lt + ((lt ^ rh) & 1)), l = l0 + fr, l0n = 16 * (2 * (lt + 1) + (((lt + 1) ^ rh) & 1));
                const float acl = AC[hh * 128 + l];
                f32x4 yd[4], yo[4]; u32x2 zc[4];
#pragma unroll
                for (int pt = 0; pt < 4; ++pt) { yd[pt] = (f32x4){0.f, 0.f, 0.f, 0.f}; yo[pt] = yd[pt]; zc[pt] = zn[pt];
                    if (lt < 3) zn[pt] = *(const u32x2*)(Z + (size_t)(tok0 + l0n + fr) * 1024 + h * 64 + 16 * pt + 4 * fq); }
#pragma unroll
                for (int i = 0; i < 4; ++i) {
                    if (32 * i <= l0 + 15) {
                        float cbv[8]; unpack8(*(const LAS u32x4*)(CBs + l * 136 + 32 * i + 8 * fq), cbv);
                        const f32x4 as0 = *(const LAS f32x4*)(AC + hh * 128 + 32 * i + 8 * fq), as1 = *(const LAS f32x4*)(AC + hh * 128 + 32 * i + 8 * fq + 4);
                        float mv[8];
#pragma unroll
                        for (int j = 0; j < 4; ++j) { const int s0 = 32 * i + 8 * fq + j;
                            mv[j] = l >= s0 ? cbv[j] * __expf(acl - as0[j]) : 0.f; mv[4 + j] = l >= s0 + 4 ? cbv[4 + j] * __expf(acl - as1[j]) : 0.f; }
                        u32x4 mw; mw.x = pk2(mv[0], mv[1]); mw.y = pk2(mv[2], mv[3]); mw.z = pk2(mv[4], mv[5]); mw.w = pk2(mv[6], mv[7]);
                        const bf16x8 mf = __builtin_bit_cast(bf16x8, mw);
#pragma unroll
                        for (int pt = 0; pt < 4; ++pt) { const bf16x8 xf = *(const LAS bf16x8*)(Xh + (16 * pt + fr) * 136 + 32 * i + 8 * fq); yd[pt] = MFMA16(xf, mf, yd[pt]); }
                    }
                }
#pragma unroll
                for (int ks = 0; ks < 4; ++ks) { const bf16x8 cfr = *(const LAS bf16x8*)(Cs + l * 136 + 32 * ks + 8 * fq);
#pragma unroll
                    for (int pt = 0; pt < 4; ++pt) yo[pt] = MFMA16(pf[pt][ks], cfr, yo[pt]); }
                const float el = __expf(acl), rdt = 1.f / DT[hh * 128 + l];
                float ssq = 0.f;
#pragma unroll
                for (int pt = 0; pt < 4; ++pt) { const int p0 = 16 * pt + 4 * fq, ch = h * 64 + p0;
                    const u32x2 zr = zc[pt]; const float zv[4] = {bflo(zr.x), bfhi(zr.x), bflo(zr.y), bfhi(zr.y)};
                    float y[4];
#pragma unroll
                    for (int j = 0; j < 4; ++j) { const float xv = bf2f(Xh[(p0 + j) * 136 + l]) * rdt; y[j] = (yd[pt][j] + el * yo[pt][j] + dsk * xv) * siluf(zv[j]); ssq += y[j] * y[j]; }
                    u32x2 o; o.x = pk2(y[0], y[1]); o.y = pk2(y[2], y[3]); *(u32x2*)(ycat + (size_t)(tok0 + l) * 2048 + ch) = o; }
                ssq += __shfl_xor(ssq, 16); ssq += __shfl_xor(ssq, 32);
                if (fq == 0) SS[hh * 128 + l] = ssq;
            }
        }
        __syncthreads();
    }
    {
        const float* ng = P.in[16];
#pragma unroll 8
        for (int r = 0; r < 16; ++r) { const int it = tid + 512 * r, row = it >> 6, g8 = it & 63, ch = gq * 512 + g8 * 8;
            float sq = 0.f;
#pragma unroll
            for (int q = 0; q < 8; ++q) sq += SS[q * 128 + row];
            const float rs = rsqrtf(sq * (1.f / 512.f) + EPS);
            bf16* yp = ycat + (size_t)(tok0 + row) * 2048 + ch; float v[8]; unpack8(*(const u32x4*)yp, v);
            const f32x4 g0 = *(const f32x4*)(ng + ch), g1 = *(const f32x4*)(ng + ch + 4);
            u32x4 o; o.x = pk2(v[0] * rs * g0[0], v[1] * rs * g0[1]); o.y = pk2(v[2] * rs * g0[2], v[3] * rs * g0[3]); o.z = pk2(v[4] * rs * g1[0], v[5] * rs * g1[1]); o.w = pk2(v[6] * rs * g1[2], v[7] * rs * g1[3]);
            *(u32x4*)yp = o; }
    }
    __syncthreads();
}

template <int PAT>
__device__ __forceinline__ void attn_phase(unsigned char* wsp, LAS unsigned char* lds) {
    constexpr int DIL = PAT == 0 ? 1 : (PAT == 1 ? 4 : 16), NB = 64 / DIL;
    const int tid = threadIdx.x, lane = tid & 63, wave = __builtin_amdgcn_readfirstlane(tid >> 6), fr = lane & 15, fq = lane >> 4;
    const bf16* QH = (const bf16*)(wsp + WS_QKV); const bf16* KH = QH + (size_t)3 * NTOK * 1024; const bf16* VH = KH + (size_t)NTOK * 1024;
    bf16* O = (bf16*)(wsp + WS_O); float* LSE = (float*)(wsp + WS_LSE);
    LAS bf16* Ks = (LAS bf16*)lds;
    LAS unsigned* Vs32 = (LAS unsigned*)(lds + 69632);
    LAS bf16* VsT = (LAS bf16*)(lds + 69632);
    u32x4 kreg[4], vreg[2][2];
#define ATT_LOAD(bh_, r_, nb_) do { \
        { const int key = tid >> 2, q4 = tid & 3; const bf16* kp = KH + ((size_t)(bh_) * 8192 + (size_t)((nb_) * 128 + key) * DIL + (r_)) * 128 + q4 * 32; \
          _Pragma("unroll") for (int i_ = 0; i_ < 4; ++i_) kreg[i_] = *(const u32x4*)(kp + i_ * 8); } \
        { const bf16* vp = VH + ((size_t)(bh_) * 8192 + (size_t)((nb_) * 128 + 2 * lane) * DIL + (r_)) * 128 + 16 * wave; \
          _Pragma("unroll") for (int g_ = 0; g_ < 2; ++g_) { vreg[g_][0] = *(const u32x4*)(vp + g_ * 8); vreg[g_][1] = *(const u32x4*)(vp + (size_t)DIL * 128 + g_ * 8); } } } while (0)
#define ATT_ZERO() do { _Pragma("unroll") for (int i_ = 0; i_ < 4; ++i_) kreg[i_] = (u32x4){0u, 0u, 0u, 0u}; \
        _Pragma("unroll") for (int g_ = 0; g_ < 2; ++g_) { vreg[g_][0] = (u32x4){0u, 0u, 0u, 0u}; vreg[g_][1] = vreg[g_][0]; } } while (0)
#define ATT_STORE(slot_) do { \
        { const int key = tid >> 2, q4 = tid & 3; _Pragma("unroll") for (int i_ = 0; i_ < 4; ++i_) *(LAS u32x4*)(Ks + ((slot_) * 128 + key) * 136 + q4 * 32 + i_ * 8) = kreg[i_]; } \
        { const int sp = (slot_) * 64 + (kperm(2 * lane) >> 1); \
          _Pragma("unroll") for (int g_ = 0; g_ < 2; ++g_) { const u32x4 a_ = vreg[g_][0], c_ = vreg[g_][1]; LAS unsigned* vd = Vs32 + (16 * wave + 8 * g_) * 132 + sp; \
            vd[0] = pair_lo(a_.x, c_.x); vd[132] = pair_hi(a_.x, c_.x); vd[2 * 132] = pair_lo(a_.y, c_.y); vd[3 * 132] = pair_hi(a_.y, c_.y); \
            vd[4 * 132] = pair_lo(a_.z, c_.z); vd[5 * 132] = pair_hi(a_.z, c_.z); vd[6 * 132] = pair_lo(a_.w, c_.w); vd[7 * 132] = pair_hi(a_.w, c_.w); } } } while (0)
#pragma unroll 1
    for (int u0 = blockIdx.x * 8; u0 < 2048; u0 += gridDim.x * 8)
#pragma unroll 1
    for (int i = 0; i < 8; ++i) {
        const int unit = u0 + i, nblk = unit % NB, r = (unit / NB) % DIL, h = (unit >> 6) & 7, b = unit >> 9, bh = b * 8 + h;
        const int cs = i & 1, ps = cs ^ 1;
        const bool chain_start = (i == 0) || (nblk == 0);
        if (chain_start) {
            if (nblk > 0) ATT_LOAD(bh, r, nblk - 1); else ATT_ZERO();
            ATT_STORE(ps);
            ATT_LOAD(bh, r, nblk);
        }
        ATT_STORE(cs);
        const int qi = 16 * wave + fr;
        const size_t qpos = (size_t)(nblk * 128 + qi) * DIL + r;
        bf16x8 qf[4];
#pragma unroll
        for (int ks = 0; ks < 4; ++ks) qf[ks] = __builtin_bit_cast(bf16x8, *(const u32x4*)(QH + (((size_t)(PAT * 4 + b) * 8 + h) * 8192 + qpos) * 128 + 32 * ks + 8 * fq));
        const size_t qtok = (size_t)b * SEQ + qpos;
        bf16* op = O + qtok * 1024 + h * 128 + 4 * fq; float* lp = LSE + qtok * 8 + h;
        u32x2 pv[8]; float lprev = 0.f;
        if (PAT != 0) { lprev = *lp;
#pragma unroll
            for (int nt = 0; nt < 8; ++nt) pv[nt] = *(const u32x2*)(op + 16 * nt); }
        __syncthreads();
        { const int un = unit + 1, nb2 = un % NB; if (i < 7 && nb2 != 0) ATT_LOAD(bh, r, nb2); }
        const int kj0 = 16 * (wave & ~1);
        f32x4 sc[10];
        float mx = -1e30f;
#pragma unroll
        for (int t = 0; t < 10; ++t) { f32x4 a = {0.f, 0.f, 0.f, 0.f};
            const int kjt = kj0 + 16 * t, krow = ((kjt >> 7) ? cs : ps) * 128 + (kjt & 127) + fr;
#pragma unroll
            for (int ks = 0; ks < 4; ++ks) { const bf16x8 kf = *(const LAS bf16x8*)(Ks + krow * 136 + 32 * ks + 8 * fq); a = MFMA16(kf, qf[ks], a); }
#pragma unroll
            for (int j = 0; j < 4; ++j) { const int kj = kjt + 4 * fq + j; const bool ok = (kj >= qi) && (kj <= qi + 128) && (nblk > 0 || kj >= 128);
                a[j] = ok ? a[j] * 0.08838834764831845f : -1e30f; mx = fmaxf(mx, a[j]); }
            sc[t] = a; }
        mx = fmaxf(mx, __shfl_xor(mx, 16)); mx = fmaxf(mx, __shfl_xor(mx, 32));
        float sum = 0.f;
#pragma unroll
        for (int t = 0; t < 10; ++t)
#pragma unroll
            for (int j = 0; j < 4; ++j) { const float pv = __expf(sc[t][j] - mx); sc[t][j] = pv; sum += pv; }
        sum += __shfl_xor(sum, 16); sum += __shfl_xor(sum, 32);
        const float lse = mx + __logf(sum);
        f32x4 o[8];
#pragma unroll
        for (int nt = 0; nt < 8; ++nt) o[nt] = (f32x4){0.f, 0.f, 0.f, 0.f};
#pragma unroll
        for (int g = 0; g < 5; ++g) { u32x4 pw; pw.x = pk2(sc[2 * g][0], sc[2 * g][1]); pw.y = pk2(sc[2 * g][2], sc[2 * g][3]); pw.z = pk2(sc[2 * g + 1][0], sc[2 * g + 1][1]); pw.w = pk2(sc[2 * g + 1][2], sc[2 * g + 1][3]);
            const bf16x8 pf = __builtin_bit_cast(bf16x8, pw);
            const int kjg = kj0 + 32 * g, kcol = ((kjg >> 7) ? cs : ps) * 128 + (kjg & 127) + 8 * fq;
#pragma unroll
            for (int nt = 0; nt < 8; ++nt) { const bf16x8 vf = *(const LAS bf16x8*)(VsT + (16 * nt + fr) * 264 + kcol); o[nt] = MFMA16(vf, pf, o[nt]); } }
        {
            if (PAT == 0) {
                const float inv = 1.f / sum;
#pragma unroll
                for (int nt = 0; nt < 8; ++nt) { u32x2 w; w.x = pk2(o[nt][0] * inv, o[nt][1] * inv); w.y = pk2(o[nt][2] * inv, o[nt][3] * inv); *(u32x2*)(op + 16 * nt) = w; }
                if (fq == 0) *lp = lse;
            } else {
                const float m2 = fmaxf(lprev, lse), nl = m2 + __logf(__expf(lprev - m2) + __expf(lse - m2));
                const float w1 = __expf(lprev - nl), w2 = __expf(lse - nl) / sum;
#pragma unroll
                for (int nt = 0; nt < 8; ++nt) { u32x2 w; w.x = pk2(w1 * bflo(pv[nt].x) + w2 * o[nt][0], w1 * bfhi(pv[nt].x) + w2 * o[nt][1]); w.y = pk2(w1 * bflo(pv[nt].y) + w2 * o[nt][2], w1 * bfhi(pv[nt].y) + w2 * o[nt][3]);
                    *(u32x2*)(op + 16 * nt) = w; }
                if (PAT == 1 && fq == 0) *lp = nl;
            }
        }
        __syncthreads();
    }
#undef ATT_LOAD
#undef ATT_ZERO
#undef ATT_STORE
}

#define XB_TMO      128
#define XB_XCNT(j)  (256  + 64 * (j))
#define XB_XSUB(j)  (1280 + 64 * (j))
#define XB_XGEN(j)  (2304 + 64 * (j))
#define XB_TOP      3328
#define XB_TOPGEN   3392
#define XCD_BAR_WORDS 3456
#define XB_SPIN_CAP (1u << 18)

__device__ __forceinline__ unsigned xb_ld(unsigned* p)              { return __hip_atomic_load(p, __ATOMIC_RELAXED, __HIP_MEMORY_SCOPE_AGENT); }
__device__ __forceinline__ unsigned xb_add(unsigned* p, unsigned v) { return __hip_atomic_fetch_add(p, v, __ATOMIC_RELAXED, __HIP_MEMORY_SCOPE_AGENT); }
__device__ __forceinline__ unsigned xb_xcc_id() { return (unsigned)__builtin_amdgcn_s_getreg((3 << 11) | 20) & 0xFu; }
#define XB_SPIN(cond, bar) do { unsigned _sp = 0; while (cond) { __builtin_amdgcn_s_sleep(1); \
    if ((++_sp & 255u) == 0u) { if (xb_ld(&(bar)[XB_TMO])) break; if (_sp > XB_SPIN_CAP) { atomicAdd(&(bar)[XB_TMO], 1u); break; } } } } while (0)

struct XcdBarrier {
    unsigned* bar; unsigned x;
    volatile LAS unsigned* st;
};

__device__ __forceinline__ XcdBarrier xcd_barrier_post(unsigned* bar, volatile LAS unsigned* st) {
    XcdBarrier b; b.bar = bar; b.x = xb_xcc_id(); b.st = st;
    if (threadIdx.x == 0) (void)xb_add(&bar[XB_XCNT(b.x)], 1u);
    return b;
}
__device__ __forceinline__ void xcd_barrier_complete(unsigned* bar, unsigned x, unsigned& nloc, unsigned& nx) {
    const unsigned G = gridDim.x * gridDim.y * gridDim.z;
    unsigned sum, cnt, mine, sp = 0u;
    for (;;) {
        sum = 0u; cnt = 0u; mine = 0u;
#pragma unroll
        for (unsigned j = 0; j < 16; ++j) { const unsigned c = xb_ld(&bar[XB_XCNT(j)]); sum += c; cnt += (c > 0u) ? 1u : 0u; mine = (j == x) ? c : mine; }
        if (sum == G) break;
        __builtin_amdgcn_s_sleep(1);
        if ((++sp & 255u) == 0u) { if (xb_ld(&bar[XB_TMO])) break; if (sp > XB_SPIN_CAP) { atomicAdd(&bar[XB_TMO], 1u); break; } }
    }
    nloc = mine > 0u ? mine : 1u; nx = cnt > 0u ? cnt : 1u;
}

__device__ __forceinline__ void xcd_barrier(const XcdBarrier& b) {
    asm volatile("s_waitcnt vmcnt(0)" ::: "memory");
    __syncthreads();
    if (threadIdx.x == 0) {
        unsigned* bar = b.bar;
        __builtin_amdgcn_s_waitcnt(0);
        unsigned nloc = b.st[0], nx = b.st[1];
        if (nloc == 0u) { xcd_barrier_complete(bar, b.x, nloc, nx); b.st[0] = nloc; b.st[1] = nx; }
        const unsigned old = xb_add(&bar[XB_XSUB(b.x)], 1u);
        const unsigned gen = old / nloc;
        if (old + 1u == (gen + 1u) * nloc) {
            __builtin_amdgcn_fence(__ATOMIC_RELEASE, "agent");
            asm volatile("s_waitcnt vmcnt(0)" ::: "memory");
            const unsigned og = xb_add(&bar[XB_TOP], 1u);
            const unsigned tg = og / nx;
            if (og + 1u == (tg + 1u) * nx) xb_add(&bar[XB_TOPGEN], 1u);
            else XB_SPIN(xb_ld(&bar[XB_TOPGEN]) == tg, bar);
            __builtin_amdgcn_fence(__ATOMIC_ACQUIRE, "agent");
            xb_add(&bar[XB_XGEN(b.x)], 1u);
            asm volatile("s_waitcnt vmcnt(0)" ::: "memory");
        } else {
            XB_SPIN(xb_ld(&bar[XB_XGEN(b.x)]) == gen, bar);
            __builtin_amdgcn_fence(__ATOMIC_ACQUIRE, "agent");
            asm volatile("s_waitcnt vmcnt(0)" ::: "memory");
        }
    }
    __syncthreads();
}

typedef const Params __attribute__((address_space(4)))* KParamsPtr;
__device__ __forceinline__ KParamsPtr kp_launder(KParamsPtr p) { asm volatile("" : "+s"(p)); return p; }
#define LOADP() Params P; __builtin_memcpy(&P, kp_launder(kp0), sizeof(Params)); unsigned char* ws = P.ws; const float* mod = (const float*)(ws + WS_MOD); (void)mod
__global__ void __launch_bounds__(512) trunk_fwd(Params Pk) {
    KParamsPtr kp0 = (KParamsPtr)__builtin_amdgcn_kernarg_segment_ptr();
    extern __shared__ __attribute__((aligned(16))) unsigned char lds_raw[];
    LAS unsigned char* lds = (LAS unsigned char*)lds_raw;
    volatile LAS unsigned* bst = (volatile LAS unsigned*)(lds + LDS_BYTES - 64);
    if (threadIdx.x < 2) bst[threadIdx.x] = 0u;
    __syncthreads();
    (void)xcd_barrier_post((unsigned*)(Pk.ws + WS_BAR) + Pk.li * 4096, bst);
#define GRID_BAR() do { XcdBarrier xb_; { Params Pb; __builtin_memcpy(&Pb, kp_launder(kp0), sizeof(Params)); xb_.bar = (unsigned*)(Pb.ws + WS_BAR) + Pb.li * 4096; } xb_.x = xb_xcc_id(); xb_.st = (volatile LAS unsigned*)(lds + LDS_BYTES - 64); xcd_barrier(xb_); } while (0)
    const int lo = Pk.ph_lo, hi = Pk.ph_hi, G = gridDim.x, bx = blockIdx.x;
#define IN(k) (lo <= (k) && (k) < hi)
#define SEAM(k) do { if (IN(k) && IN((k) + 1)) { GRID_BAR(); } } while (0)
#define REPB(k) _Pragma("unroll 1") for (int rep = 0; rep < REP[k]; ++rep) { if (rep) GRID_BAR();
#define REPE }
    using namespace pg8;
    if (IN(0)) { LOADP(); REPB(0)
    phase_prologue(P, lds);
    REPE }
    SEAM(0);
    if (IN(1)) { LOADP(); REPB(1)
    phase_norm<0, 0, 0>(P, lds, P.in[0], nullptr, nullptr, nullptr, P.in[4], mod + 1024, mod);
    REPE }
    SEAM(1);
    if (IN(2)) { LOADP(); REPB(2)
    { Gemm g{(const bf16*)(ws + WS_H), (const bf16*)(ws + WS_WHYBIN), 1024, 1024, 1024}; StaticOrder S; S.init(NTOK, 3584, G, bx);
            EpiHybIn E{(bf16*)(ws + WS_Z), (bf16*)P.out, (bf16*)(ws + WS_UG)}; gemm_phase(lds, g, S, E); }
    REPE }
    SEAM(2);
    if (IN(3)) { LOADP(); REPB(3)
        phase_conv(P);
    REPE }
    SEAM(3);
    if (IN(4)) { LOADP(); REPB(4)
    {
            for (int u = bx; u < 512; u += G) ssd_local_unit(P, lds, u);
            Gemm g{(const bf16*)(ws + WS_UG), (const bf16*)(ws + WS_BPOW), 384, 256, 256}; GroupOrder S{G, bx}; EpiS5State E{(float*)(ws + WS_HLOC)}; gemm_phase(lds, g, S, E); }
    REPE }
    SEAM(4);
    if (IN(5)) { LOADP(); REPB(5)
    phase_scans(P);
    REPE }
    SEAM(5);
    if (IN(6)) { LOADP(); REPB(6)
    {
            for (int u = bx; u < 512; u += G) ssd_out_unit(P, lds, u);
            Gemm g{(const bf16*)(ws + WS_UG), (const bf16*)(ws + WS_TOEC), 384, 384, 384}; GroupOrder S{G, bx}; EpiS5Y E{(const bf16*)(ws + WS_UG), P.in[24], (bf16*)(ws + WS_S5Y)}; gemm_phase(lds, g, S, E); }
    REPE }
    SEAM(6);
    if (IN(7)) { LOADP(); REPB(7)
    { Gemm g{(const bf16*)(ws + WS_S5Y), (const bf16*)(ws + WS_WGLU), 1024, 1024, 1024}; StaticOrder S; S.init(NTOK, 1024, G, bx);
            EpiGlu E{(const bf16*)(ws + WS_S5Y), P.in[26], (bf16*)P.out}; gemm_phase(lds, g, S, E); }
    REPE }
    SEAM(7);
    if (IN(8)) { LOADP(); REPB(8)
    { Gemm g{(const bf16*)P.out, (const bf16*)(ws + WS_WHYBOUT), 2048, 2048, 2048}; StaticOrder S; S.init(NTOK, 1024, G, bx);
            EpiPlain E{(bf16*)(ws + WS_Y), 1024}; gemm_phase(lds, g, S, E); }
    REPE }
    SEAM(8);
    if (IN(9)) { LOADP(); REPB(9)
    phase_norm<1, 0, 1>(P, lds, P.in[0], P.out, P.in[5], mod + 2048, P.in[6], mod + 4096, mod + 3072);
    REPE }
    SEAM(9);
    if (IN(10)) { LOADP(); REPB(10)
    { Gemm g{(const bf16*)(ws + WS_H), (const bf16*)(ws + WS_WFFIN), 1024, 1024, 1024}; StaticOrder S; S.init(NTOK, 5632, G, bx);
            EpiSwiglu E{(bf16*)(ws + WS_HID)}; gemm_phase(lds, g, S, E); }
    REPE }
    SEAM(10);
    if (IN(11)) { LOADP(); REPB(11)
    { Gemm g{(const bf16*)(ws + WS_HID), (const bf16*)(ws + WS_WFFOUT), 2816, 2816, 2816}; StaticOrder S; S.init(NTOK, 1024, G, bx);
            EpiPlain E{(bf16*)(ws + WS_Y), 1024}; gemm_phase(lds, g, S, E); }
    REPE }
    SEAM(11);
    if (IN(12)) { LOADP(); REPB(12)
    phase_norm<1, 1, 1>(P, lds, P.out, P.out, P.in[7], mod + 5120, P.in[4] + 1024, mod + 4 * 6144 + 1024, mod + 4 * 6144);
    REPE }
    SEAM(12);
    if (IN(13)) { LOADP(); REPB(13)
    { Gemm g{(const bf16*)(ws + WS_H), (const bf16*)(ws + WS_WQKV), 1024, 1024, 1024}; StaticOrder S; S.init(NTOK, 5120, G, bx);
            EpiQKV E{(bf16*)(ws + WS_QKV)}; gemm_phase(lds, g, S, E); }
    REPE }
    SEAM(13);
    if (IN(14)) { LOADP(); REPB(14)
    attn_phase<0>(ws, lds);
    REPE }
    SEAM(14);
    if (IN(15)) { LOADP(); REPB(15)
    attn_phase<1>(ws, lds);
    REPE }
    SEAM(15);
    if (IN(16)) { LOADP(); REPB(16)
    attn_phase<2>(ws, lds);
    REPE }
    SEAM(16);
    if (IN(17)) { LOADP(); REPB(17)
    { Gemm g{(const bf16*)(ws + WS_O), (const bf16*)(ws + WS_WO), 1024, 1024, 1024}; StaticOrder S; S.init(NTOK, 1024, G, bx);
            EpiPlain E{(bf16*)(ws + WS_Y), 1024}; gemm_phase(lds, g, S, E); }
    REPE }
    SEAM(17);
    if (IN(18)) { LOADP(); REPB(18)
    phase_norm<1, 1, 1>(P, lds, P.out, ws + WS_XB2, P.in[5] + 1024, mod + 4 * 6144 + 2048, P.in[6] + 1024, mod + 4 * 6144 + 4096, mod + 4 * 6144 + 3072);
    REPE }
    SEAM(18);
    if (IN(19)) { LOADP(); REPB(19)
    { Gemm g{(const bf16*)(ws + WS_H), (const bf16*)(ws + WS_WFFIN) + (size_t)5632 * 1024, 1024, 1024, 1024}; StaticOrder S; S.init(NTOK, 5632, G, bx);
            EpiSwiglu E{(bf16*)(ws + WS_HID)}; gemm_phase(lds, g, S, E); }
    REPE }
    SEAM(19);
    if (IN(20)) { LOADP(); REPB(20)
    { Gemm g{(const bf16*)(ws + WS_HID), (const bf16*)(ws + WS_WFFOUT) + (size_t)1024 * 2816, 2816, 2816, 2816}; StaticOrder S; S.init(NTOK, 1024, G, bx);
            EpiPlain E{(bf16*)(ws + WS_Y), 1024}; gemm_phase(lds, g, S, E); }
    REPE }
    SEAM(20);
    if (IN(21)) { LOADP(); REPB(21)
    phase_norm<2, 1, 0>(P, lds, ws + WS_XB2, P.out, P.in[7] + 1024, mod + 4 * 6144 + 5120, nullptr, nullptr, nullptr);
    REPE }
#undef IN
#undef SEAM
}

extern "C" void kernel_launch(void* const* d_in, const int* in_sizes, int n_in, void* d_out, int out_size, void* d_ws, size_t ws_size, hipStream_t stream) {
    static int grid = 0;
    if (grid == 0) {
        if (n_in != 30 || out_size != NTOK * DM || ws_size < WS_END) { fprintf(stderr, "kernel_launch: unexpected shapes (n_in %d out %d ws %zu)\n", n_in, out_size, ws_size); grid = -1; return; }
        int dev = 0, cus = 0, per_cu = 0;
        hipGetDevice(&dev); hipDeviceGetAttribute(&cus, hipDeviceAttributeMultiprocessorCount, dev);
        if (hipFuncSetAttribute((const void*)trunk_fwd, hipFuncAttributeMaxDynamicSharedMemorySize, LDS_BYTES) != hipSuccess) { fprintf(stderr, "kernel_launch: hipFuncSetAttribute failed\n"); grid = -1; return; }
        if (hipOccupancyMaxActiveBlocksPerMultiprocessor(&per_cu, (const void*)trunk_fwd, 512, LDS_BYTES) != hipSuccess || per_cu < 1) { fprintf(stderr, "kernel_launch: occupancy query says %d\n", per_cu); per_cu = 1; }
        (void)hipGetLastError();
        grid = cus;
        if (grid > cus * per_cu) grid = cus * per_cu;
        if (grid != 256) { fprintf(stderr, "kernel_launch: this build's phase bodies assume a 256-workgroup grid (256 CUs); got %d; nothing launched\n", grid); grid = -1; return; }
    }
    if (grid < 0) return;
    hipMemsetAsync(d_ws, 0, 1 * MiB, stream);
    Params p{};
    for (int i = 0; i < 30; ++i) p.in[i] = (const float*)d_in[i];
    p.out = (float*)d_out; p.ws = (unsigned char*)d_ws;
    static const int launches[] = {LAUNCH_LIST};
    for (unsigned li = 0; li + 1 < sizeof(launches) / sizeof(int); li += 2) { p.ph_lo = launches[li]; p.ph_hi = launches[li + 1]; p.li = (int)(li / 2); void* args[] = {&p};
        hipError_t e = hipLaunchCooperativeKernel((void*)trunk_fwd, dim3(grid), dim3(512), args, LDS_BYTES, stream);
        if (e != hipSuccess) { fprintf(stderr, "cooperative launch failed: %s (grid %d)\n", hipGetErrorString(e), grid); break; } }
}
```
